# Optimizing an MI355X kernel written in HIP

```python
import jax, jax.numpy as jnp
from jax import lax
import numpy as np

D_MODEL = 1024
BATCH = 16
SEQ = 4096
DEPTH = 4

N_MIXERS = 2
N_CONV_LAYERS = (DEPTH + 1) // 2
N_ATTN_LAYERS = DEPTH // 2
CONV_W = 3
N_HEADS = 16
HEAD_DIM = D_MODEL // N_HEADS
Q_BLOCK = 128
N_EXPERTS = 32
TOP_K = 4
D_FF = D_MODEL
SWIGLU_LIMIT = 7.0
SWIGLU_ALPHA = 1.702
EXPERT_BLOCK = 512
EPS = 1e-6

kernel_name = "hybrid_shortconv_stickbreaking_moe_adaln"


def rms_norm(x, g):
    xf = x.astype(jnp.float32)
    y = xf * lax.rsqrt(jnp.mean(xf * xf, axis=-1, keepdims=True) + EPS)
    return (y * g.astype(jnp.float32)).astype(x.dtype)


def short_conv_mixer(h, w_in, conv_w, w_out):
    S = h.shape[1]
    proj = h @ w_in
    b_gate, c_gate, u = jnp.split(proj, 3, axis=-1)
    v = c_gate * u
    vp = jnp.pad(v, ((0, 0), (CONV_W - 1, 0), (0, 0)))
    y = conv_w[CONV_W - 1] * v
    for k in range(CONV_W - 1):
        y = y + conv_w[k] * vp[:, k:k + S]
    return (b_gate * y) @ w_out


def stick_breaking_mixer(h, w_qkv, q_g, k_g, w_o):
    B, S, D = h.shape
    qkv = (h @ w_qkv).reshape(B, S, 3, N_HEADS, HEAD_DIM)
    q = rms_norm(qkv[:, :, 0], q_g).transpose(0, 2, 1, 3)
    k = rms_norm(qkv[:, :, 1], k_g).transpose(0, 2, 1, 3)
    v = qkv[:, :, 2].transpose(0, 2, 1, 3)
    n_blocks = S // Q_BLOCK
    q_blocks = q.reshape(B, N_HEADS, n_blocks, Q_BLOCK, HEAD_DIM).transpose(2, 0, 1, 3, 4)
    k32 = k.astype(jnp.float32)
    key_pos = jnp.arange(S)
    scale = HEAD_DIM ** -0.5

    def block(args):
        i, qi = args
        z = jnp.einsum('bhqd,bhkd->bhqk', qi.astype(jnp.float32), k32) * scale
        t = i * Q_BLOCK + jnp.arange(Q_BLOCK)
        mask = key_pos[None, :] < t[:, None]
        log_beta = jax.nn.log_sigmoid(z)
        log_1m = jnp.where(mask, log_beta - z, 0.0)
        suffix = lax.cumsum(log_1m, axis=3, reverse=True) - log_1m
        a = jnp.where(mask, jnp.exp(log_beta + suffix), 0.0)
        return jnp.einsum('bhqk,bhkd->bhqd', a.astype(v.dtype), v)

    o = lax.map(block, (jnp.arange(n_blocks), q_blocks))
    o = o.transpose(1, 0, 3, 2, 4).reshape(B, S, D)
    return o @ w_o


def moe_ffn(h, router_w, router_b, w1, b1, w2, b2):
    B, S, D = h.shape
    xt = h.reshape(-1, D)
    n_tok = xt.shape[0]
    logits = (xt @ router_w).astype(jnp.float32) + router_b.astype(jnp.float32)
    top_logits, top_idx = lax.top_k(logits, TOP_K)
    gates = jax.nn.softmax(top_logits, axis=-1)

    n_assign = n_tok * TOP_K
    e_flat = top_idx.reshape(-1)
    order = jnp.argsort(e_flat)
    e_sorted = e_flat[order]
    tok_sorted = (order // TOP_K).astype(jnp.int32)
    g_sorted = gates.reshape(-1)[order]
    counts = jnp.bincount(e_flat, length=N_EXPERTS)
    padded = (counts + EXPERT_BLOCK - 1) // EXPERT_BLOCK * EXPERT_BLOCK
    start = jnp.cumsum(counts) - counts
    padded_end = jnp.cumsum(padded)
    padded_start = padded_end - padded
    dest = padded_start[e_sorted] + jnp.arange(n_assign) - start[e_sorted]
    n_blocks = -(-n_assign // EXPERT_BLOCK) + N_EXPERTS
    n_pad = n_blocks * EXPERT_BLOCK
    pad_tok = jnp.full((n_pad,), n_tok, jnp.int32).at[dest].set(tok_sorted)
    pad_gate = jnp.zeros((n_pad,), jnp.float32).at[dest].set(g_sorted)
    block_expert = jnp.clip(
        jnp.searchsorted(padded_end, jnp.arange(n_blocks) * EXPERT_BLOCK, side='right'),
        0, N_EXPERTS - 1)
    x_pad = jnp.concatenate([xt, jnp.zeros((1, D), xt.dtype)], axis=0)

    def step(acc, inp):
        e, tok, g = inp
        xb = x_pad[tok]
        gu = xb @ w1[e] + b1[e]
        g_h = jnp.minimum(gu[:, :D_FF], SWIGLU_LIMIT)
        u_h = jnp.clip(gu[:, D_FF:], -SWIGLU_LIMIT, SWIGLU_LIMIT)
        act = (u_h + 1.0) * (g_h * jax.nn.sigmoid(SWIGLU_ALPHA * g_h))
        y = act @ w2[e] + b2[e]
        return acc.at[tok].add(y * g[:, None].astype(y.dtype)), None

    acc, _ = lax.scan(step, jnp.zeros((n_tok + 1, D), h.dtype),
                      (block_expert, pad_tok.reshape(n_blocks, EXPERT_BLOCK),
                       pad_gate.reshape(n_blocks, EXPERT_BLOCK)))
    return acc[:n_tok].reshape(B, S, D)


def setup_inputs(seed: int = 0) -> dict:
    key = jax.random.key(seed)
    ks = jax.random.split(key, 20)
    D, E, F = D_MODEL, N_EXPERTS, D_FF
    nrm = lambda k, shape, s: jax.random.normal(k, shape, jnp.float32) * s
    return {
        "x": nrm(ks[0], (BATCH, SEQ, D), 1.0),
        "c": nrm(ks[1], (BATCH, D), 1.0),
        "norm1_g": 1.0 + nrm(ks[2], (DEPTH, D), 0.02),
        "norm2_g": 1.0 + nrm(ks[3], (DEPTH, D), 0.02),
        "ada_w": nrm(ks[4], (DEPTH, D, 6 * D), 0.5 * D ** -0.5),
        "ada_b": nrm(ks[5], (DEPTH, 6 * D), 0.02),
        "conv_w_in": nrm(ks[6], (N_CONV_LAYERS, D, 3 * D), D ** -0.5),
        "conv_w": nrm(ks[7], (N_CONV_LAYERS, CONV_W, D), CONV_W ** -0.5),
        "conv_w_out": nrm(ks[8], (N_CONV_LAYERS, D, D), D ** -0.5),
        "attn_w_qkv": nrm(ks[9], (N_ATTN_LAYERS, D, 3 * D), D ** -0.5),
        "attn_q_g": 1.0 + nrm(ks[10], (N_ATTN_LAYERS, HEAD_DIM), 0.02),
        "attn_k_g": 1.0 + nrm(ks[11], (N_ATTN_LAYERS, HEAD_DIM), 0.02),
        "attn_w_o": nrm(ks[12], (N_ATTN_LAYERS, D, D), D ** -0.5),
        "router_w": nrm(ks[13], (DEPTH, D, E), D ** -0.5),
        "router_b": nrm(ks[14], (DEPTH, E), 0.01),
        "moe_w1": nrm(ks[15], (DEPTH, E, D, 2 * F), D ** -0.5),
        "moe_b1": nrm(ks[16], (DEPTH, E, 2 * F), 0.02),
        "moe_w2": nrm(ks[17], (DEPTH, E, F, D), F ** -0.5),
        "moe_b2": nrm(ks[18], (DEPTH, E, D), 0.02),
    }


def reference(x, c, norm1_g, norm2_g, ada_w, ada_b, conv_w_in, conv_w, conv_w_out,
              attn_w_qkv, attn_q_g, attn_k_g, attn_w_o, router_w, router_b,
              moe_w1, moe_b1, moe_w2, moe_b2):
    c_act = jax.nn.silu(c)
    for i in range(DEPTH):
        mod = c_act @ ada_w[i] + ada_b[i]
        sh1, sc1, gt1, sh2, sc2, gt2 = [m[:, None, :] for m in jnp.split(mod, 6, axis=-1)]
        h = rms_norm(x, norm1_g[i]) * (1.0 + sc1) + sh1
        j = i // N_MIXERS
        if i % N_MIXERS == 0:
            y = short_conv_mixer(h, conv_w_in[j], conv_w[j], conv_w_out[j])
        else:
            y = stick_breaking_mixer(h, attn_w_qkv[j], attn_q_g[j], attn_k_g[j], attn_w_o[j])
        x = x + gt1 * y
        h = rms_norm(x, norm2_g[i]) * (1.0 + sc2) + sh2
        x = x + gt2 * moe_ffn(h, router_w[i], router_b[i], moe_w1[i], moe_b1[i],
                               moe_w2[i], moe_b2[i])
    return x
```

```cpp
#include <hip/hip_runtime.h>
#include <cstdio>
#include <cstdint>

#define LAS __attribute__((address_space(3)))
#define GAS __attribute__((address_space(1)))
typedef unsigned short bf16_t;
typedef short bf16x8 __attribute__((ext_vector_type(8)));
typedef short s16x4 __attribute__((ext_vector_type(4)));
typedef float f32x4 __attribute__((ext_vector_type(4)));
typedef float f32x2 __attribute__((ext_vector_type(2)));
typedef float f32x16 __attribute__((ext_vector_type(16)));
typedef unsigned u32x4 __attribute__((ext_vector_type(4)));
typedef unsigned u32x2 __attribute__((ext_vector_type(2)));
typedef GAS unsigned gu32;
typedef int i32x4 __attribute__((ext_vector_type(4)));
typedef int i32x8 __attribute__((ext_vector_type(8)));

constexpr int D = 1024, NB = 16, SEQ = 4096, NTOK = NB * SEQ, DEPTH = 4, NH = 16, HD = 64, NE = 32, TOPK = 4, FF = 1024;
constexpr int CAP = NTOK;
constexpr int NROWS_PAD = NTOK * TOPK + NE * 256;
constexpr float EPS = 1e-6f;
constexpr float C2 = 0.125f * 1.4426950408889634f;

constexpr size_t MiB = 1u << 20;
constexpr size_t WS_CTL = 0, CTL_ZERO_BYTES = 1 * MiB;
constexpr size_t WS_MOD = 1 * MiB;
constexpr size_t WS_WR = 3 * MiB;
constexpr size_t WS_WCIN = 4 * MiB;
constexpr size_t WS_WCOUT = 16 * MiB;
constexpr size_t WS_WQKV = 20 * MiB;
constexpr size_t WS_WO = 32 * MiB;
constexpr size_t WS_W1 = 64 * MiB;
constexpr size_t WS_W2 = 576 * MiB;
constexpr size_t WS_H = 832 * MiB;
constexpr size_t WS_A1 = 960 * MiB;
constexpr size_t WS_A2 = 1088 * MiB;
constexpr size_t WS_A3 = 1216 * MiB;
constexpr size_t WS_ACT = 1344 * MiB;
constexpr size_t WS_H8 = 704 * MiB;
constexpr size_t WS_Y = 1872 * MiB;
constexpr size_t WS_TOK = 2400 * MiB;
constexpr size_t WS_GL = 2408 * MiB;
constexpr size_t WS_SLOT = 2416 * MiB;
constexpr size_t WS_XB = 2418 * MiB;
constexpr size_t WS_END = 2546 * MiB;
static_assert(WS_ACT + (size_t)NROWS_PAD * 2048 <= WS_Y && WS_Y + (size_t)NROWS_PAD * 2048 <= WS_TOK, "ws map");
constexpr int CW_BAR = 4096;
constexpr int CW_CNT = 16384;

constexpr int RING_BYTES = 131072;
constexpr int LDSCTL_OFF = 151552;
constexpr int MISC_OFF = LDSCTL_OFF + 64;
constexpr int TAB_OFF = LDSCTL_OFF + 256;
constexpr int TOKTAB_OFF = LDSCTL_OFF + 1024;
constexpr int TINFO_OFF = LDSCTL_OFF + 4096;
constexpr int LDS_BYTES = TINFO_OFF + 1056 * 4;

#define RLX_AGENT __ATOMIC_RELAXED, __HIP_MEMORY_SCOPE_AGENT
#define LDS_WAIT() asm volatile("s_waitcnt lgkmcnt(0)" ::: "memory")
#define VM_WAIT() asm volatile("s_waitcnt vmcnt(0)" ::: "memory")

__device__ __forceinline__ unsigned cvt_pk_bf16(float lo, float hi) { unsigned r; asm volatile("v_cvt_pk_bf16_f32 %0, %1, %2" : "=v"(r) : "v"(lo), "v"(hi)); return r; }
__device__ __forceinline__ unsigned cvt_pk4_fp8(float a, float b, float c, float d) { int r = __builtin_amdgcn_cvt_pk_fp8_f32(a, b, 0, false); r = __builtin_amdgcn_cvt_pk_fp8_f32(c, d, r, true); return (unsigned)r; }
__device__ __forceinline__ float bf_lo(unsigned w) { return __uint_as_float(w << 16); }
__device__ __forceinline__ float bf_hi(unsigned w) { return __uint_as_float(w & 0xffff0000u); }
__device__ __forceinline__ unsigned char* opaque_ptr(unsigned char* p) { asm volatile("" : "+s"(p)); return (unsigned char*)(GAS unsigned char*)p; }
__device__ __forceinline__ int opaque_sint(int v) { asm volatile("" : "+s"(v)); return v; }
__device__ __forceinline__ int opaque_tid() { int t = threadIdx.x; asm volatile("" : "+v"(t)); return t; }
__device__ __forceinline__ float wave_sum(float v) {
#pragma unroll
    for (int o = 1; o < 64; o <<= 1) v += __shfl_xor(v, o);
    return v;
}

#define XB_TMO      128
#define XB_XCNT(j)  (256  + 64 * (j))
#define XB_XSUB(j)  (1280 + 64 * (j))
#define XB_XGEN(j)  (2304 + 64 * (j))
#define XB_TOP      3328
#define XB_TOPGEN   3392
#define XCD_BAR_WORDS 3456
#define XB_SPIN_CAP (1u << 22)

__device__ __forceinline__ unsigned xb_ld(unsigned* p)              { return __hip_atomic_load(p, __ATOMIC_RELAXED, __HIP_MEMORY_SCOPE_AGENT); }
__device__ __forceinline__ unsigned xb_add(unsigned* p, unsigned v) { return __hip_atomic_fetch_add(p, v, __ATOMIC_RELAXED, __HIP_MEMORY_SCOPE_AGENT); }
__device__ __forceinline__ unsigned xb_xcc_id() { return (unsigned)__builtin_amdgcn_s_getreg((3 << 11) | 20) & 0xFu; }
#define XB_SPIN(cond, bar) do { unsigned _sp = 0; while (cond) { __builtin_amdgcn_s_sleep(1); \
    if ((++_sp & 255u) == 0u) { if (xb_ld(&(bar)[XB_TMO])) break; if (_sp > XB_SPIN_CAP) { atomicAdd(&(bar)[XB_TMO], 1u); break; } } } } while (0)

struct XcdBarrier { unsigned* bar; unsigned x; volatile LAS unsigned* st; };

__device__ __forceinline__ XcdBarrier xcd_barrier_post(unsigned* bar, volatile LAS unsigned* st) {
    XcdBarrier b; b.bar = bar; b.x = xb_xcc_id(); b.st = st;
    if (threadIdx.x == 0) (void)xb_add(&bar[XB_XCNT(b.x)], 1u);
    return b;
}
__device__ __forceinline__ void xcd_barrier_complete(unsigned* bar, unsigned x, unsigned& nloc, unsigned& nx) {
    const unsigned G = gridDim.x * gridDim.y * gridDim.z;
    unsigned sum, cnt, mine, sp = 0u;
    for (;;) {
        sum = 0u; cnt = 0u; mine = 0u;
#pragma unroll
        for (unsigned j = 0; j < 16; ++j) { const unsigned c = xb_ld(&bar[XB_XCNT(j)]); sum += c; cnt += (c > 0u) ? 1u : 0u; mine = (j == x) ? c : mine; }
        if (sum == G) break;
        __builtin_amdgcn_s_sleep(1);
        if ((++sp & 255u) == 0u) { if (xb_ld(&bar[XB_TMO])) break; if (sp > XB_SPIN_CAP) { atomicAdd(&bar[XB_TMO], 1u); break; } }
    }
    nloc = mine > 0u ? mine : 1u; nx = cnt > 0u ? cnt : 1u;
}
__device__ __forceinline__ void xcd_barrier(const XcdBarrier& b) {
    asm volatile("s_waitcnt vmcnt(0)" ::: "memory");
    __syncthreads();
    if (threadIdx.x == 0) {
        unsigned* bar = b.bar;
        __builtin_amdgcn_s_waitcnt(0);
        unsigned nloc = b.st[0], nx = b.st[1];
        if (nloc == 0u) { xcd_barrier_complete(bar, b.x, nloc, nx); b.st[0] = nloc; b.st[1] = nx; }
        const unsigned old = xb_add(&bar[XB_XSUB(b.x)], 1u);
        const unsigned gen = old / nloc;
        if (old + 1u == (gen + 1u) * nloc) {
            __builtin_amdgcn_fence(__ATOMIC_RELEASE, "agent");
            asm volatile("s_waitcnt vmcnt(0)" ::: "memory");
            const unsigned og = xb_add(&bar[XB_TOP], 1u);
            const unsigned tg = og / nx;
            if (og + 1u == (tg + 1u) * nx) xb_add(&bar[XB_TOPGEN], 1u);
            else XB_SPIN(xb_ld(&bar[XB_TOPGEN]) == tg, bar);
            __builtin_amdgcn_fence(__ATOMIC_ACQUIRE, "agent");
            xb_add(&bar[XB_XGEN(b.x)], 1u);
            asm volatile("s_waitcnt vmcnt(0)" ::: "memory");
        } else {
            XB_SPIN(xb_ld(&bar[XB_XGEN(b.x)]) == gen, bar);
            __builtin_amdgcn_fence(__ATOMIC_ACQUIRE, "agent");
            asm volatile("s_waitcnt vmcnt(0)" ::: "memory");
        }
    }
    __syncthreads();
}

namespace pg8 {
constexpr int BM = 256, BK = 64, HALF = 128, HTB = HALF * BK * 2, STAGE_BYTES = 8 * HTB, NXCD = 8, WGM = 8;
__device__ __forceinline__ int lds_byte(int r, int c) { const int st = (r >> 4) * 2 + (c >> 5), rr = r & 15, cc = c & 31, ob = rr * 64 + cc * 2; return st * 1024 + (ob ^ (((ob >> 9) & 1) << 5)); }
__device__ __forceinline__ void stage_rc(int b, int& R, int& C) { const int st = b / 1024, sb = b % 1024, swz = sb ^ (((sb >> 9) & 1) << 5); R = (st >> 1) * 16 + swz / 64; C = (st & 1) * 32 + (swz % 64) / 2; }
__device__ __forceinline__ int perm32(int rho) { const int n = rho >> 4, i = rho & 15; return 8 * (i >> 2) + 4 * n + (i & 3); }

struct Unit { int pm, pn, e, mrel, pnl; };

struct StaticOrder {
    static constexpr bool GATHER = false;
    int nM, nN, G, c;
    __device__ void init(int M, int N, int G_, int c_) { nM = M / BM; nN = N / BM; G = G_; c = c_; }
    static constexpr int nwg = (NTOK / BM) * (3072 / BM);
    __device__ __forceinline__ bool next(int i, Unit& u) const {
        const long L = (long)i * G + c; if (L >= nwg) return false;
        int wgid = (int)L; { const int q = nwg / NXCD, r = nwg % NXCD, xcd = wgid % NXCD, off = wgid / NXCD; wgid = (xcd < r ? xcd * (q + 1) : r * (q + 1) + (xcd - r) * q) + off; }
        constexpr int cnN = 3072 / BM, nig = WGM * cnN; const int gid = wgid / nig, rem = wgid % nig, fm = gid * WGM;
        u.pm = fm + (rem % WGM); u.pn = rem / WGM; u.e = 0; u.mrel = 0; u.pnl = u.pn; return true;
    }
    static constexpr bool TABLE = false;
    __device__ __forceinline__ int row_tok(const Unit& u, int row) const { return u.pm * BM + row; }
    __device__ __forceinline__ int row_tok_lds(const Unit& u, int row, const LAS int*) const { return u.pm * BM + row; }
    __device__ __forceinline__ const int* tok_src(const Unit&) const { return nullptr; }
};
struct PanelOrder {
    static constexpr bool GATHER = false; static constexpr bool TABLE = false;
    int nM, nN, G, c;
    __device__ void init(int M, int N, int G_, int c_) { nM = M / BM; nN = N / BM; G = G_; c = c_; }
    __device__ __forceinline__ bool next(int i, Unit& u) const { constexpr int cnN = D / BM; const int p = c + (i / cnN) * G; if (p >= nM) return false; u.pm = p; u.pn = (i + c) % cnN;
        u.e = 0; u.mrel = 0; u.pnl = u.pn; return true; }
    __device__ __forceinline__ int row_tok(const Unit& u, int row) const { return u.pm * BM + row; }
    __device__ __forceinline__ int row_tok_lds(const Unit& u, int row, const LAS int*) const { return u.pm * BM + row; }
    __device__ __forceinline__ const int* tok_src(const Unit&) const { return nullptr; }
};
struct PanelOrderG : PanelOrder { static constexpr bool GATHER = true; };
struct StaticOrderG : StaticOrder { static constexpr bool GATHER = true; };
struct MoeOrder {
    const LAS int* tab; const int* toks; int nN, Tm, nwg, G, c, lgn;
    __device__ void init(const LAS int* tab_, const int* toks_, int nN_, int G_, int c_) { tab = tab_; toks = toks_; nN = nN_; Tm = tab_[32]; nwg = Tm * nN_; G = G_; c = c_; lgn = nN_ == 8 ? 6 : 5; }
    __device__ __forceinline__ bool next(int i, Unit& u) const {
        const long L = (long)i * G + c; if (L >= nwg) return false;
        int wgid = (int)L; { const int q = nwg / NXCD, r = nwg % NXCD, xcd = wgid % NXCD, off = wgid / NXCD; wgid = (xcd < r ? xcd * (q + 1) : r * (q + 1) + (xcd - r) * q) + off; }
        const int gid = wgid >> lgn, rem = wgid & ((1 << lgn) - 1), fm = gid * WGM, gsz = (Tm - fm) < WGM ? (Tm - fm) : WGM;
        int mt, pnl; if (gsz == WGM) { mt = fm + (rem & (WGM - 1)); pnl = rem / WGM; } else { mt = fm + rem % gsz; pnl = rem / gsz; }
        const int ti = __builtin_amdgcn_readfirstlane(tab[(TINFO_OFF - TAB_OFF) / 4 + mt]);
        const int e = ti >> 16;
        u.pm = mt; u.e = e; u.mrel = ti & 0xffff; u.pnl = pnl; u.pn = e * nN + pnl; return true;
    }
    __device__ __forceinline__ const int* tok_src(const Unit& u) const { return toks + (size_t)u.e * CAP + u.mrel * 256; }
    __device__ __forceinline__ int row_tok_lds(const Unit& u, int row, const LAS int* tt) const { const int p = u.mrel * 256 + row, cnt = tab[40 + u.e]; const int t = tt[row]; return p < cnt ? t : 0; }
    __device__ __forceinline__ int row_tok(const Unit& u, int row) const {
        const int p = u.mrel * 256 + row, cnt = tab[40 + u.e];
        const int t = ((const GAS int*)toks)[(size_t)u.e * CAP + (p < cnt ? p : cnt - 1)];
        return p < cnt ? t : 0;
    }
};
template <bool GTH> struct MoeOrderT : MoeOrder { static constexpr bool GATHER = GTH; static constexpr bool TABLE = GTH; };
struct MoeOrderI : MoeOrder { static constexpr bool GATHER = true; static constexpr bool TABLE = false;
    __device__ __forceinline__ int row_tok(const Unit& u, int row) const { return u.pm * BM + row; }
    __device__ __forceinline__ int row_tok_lds(const Unit& u, int row, const LAS int*) const { return u.pm * BM + row; } };

template <class Epi, class Sched, bool ALIGN_EPI, int ESZ>
__device__ __forceinline__ void gemm_phase(LAS unsigned char* lds, const void* Aptr, const void* Btptr, const int Kel, const Sched& S, const Epi& E) {
    const int K = Kel * ESZ / 2;
    const int tid = opaque_tid(), wid = __builtin_amdgcn_readfirstlane(tid >> 6), lane = tid & 63, wr = wid >> 2, wc = wid & 3, fr = lane & 15, fq = lane >> 4;
    const int nt = K / BK;
    unsigned voffA[2], voffB[2];
#pragma unroll
    for (int i = 0; i < 2; ++i) { int R, C; stage_rc(tid * 16 + i * 8192, R, C); const int Rb = Epi::PERM ? ((R & ~31) + perm32(R & 31)) : R; voffA[i] = (unsigned)(R * K + C) * 2u; voffB[i] = (unsigned)(Rb * K + C) * 2u; }
    const size_t kstep = (size_t)(BK * 2);
    const size_t hstep = (size_t)HALF * K * 2;
    const size_t tstep = 2 * hstep;
    const unsigned ldsw = (unsigned)wid * 1024u;
    LAS unsigned char* ldsA = lds + lds_byte(wr * 64 + fr, fq * 8); LAS unsigned char* ldsB = lds + 4 * HTB + lds_byte(wc * 32 + fr, fq * 8);
    asm volatile("" : "+v"(ldsA), "+v"(ldsB));
#define PG8_SA(b, h) (((b) * 2 + (h)) * HTB)
#define PG8_SB(b, h) ((4 + (b) * 2 + (h)) * HTB)
#define PG8_STAGE(bufoff, gbase, voff) do { const char* _gb = (const char*)(gbase); asm volatile("" : "+s"(_gb)); _Pragma("unroll") for (int _i = 0; _i < 2; ++_i) { unsigned _vo = (voff)[_i]; asm volatile("" : "+v"(_vo)); \
        __builtin_amdgcn_global_load_lds((const unsigned*)(_gb + _vo), (LAS unsigned*)(lds + (bufoff) + ldsw + _i * 8192), 16, 0, 0); } } while (0)
#define PG8_LDA(dst, b, h) do { _Pragma("unroll") for (int m = 0; m < 4; ++m) { if constexpr (ESZ == 2) { _Pragma("unroll") for (int k = 0; k < 2; ++k) dst[m][k] = *(const LAS bf16x8*)(ldsA + PG8_SA(b, h) + m * 2048 + k * 1024); } \
        else { dst##8[m] = __builtin_shufflevector(*(const LAS i32x4*)(ldsA + PG8_SA(b, h) + m * 2048), *(const LAS i32x4*)(ldsA + PG8_SA(b, h) + m * 2048 + 1024), 0, 1, 2, 3, 4, 5, 6, 7); } } } while (0)
#define PG8_LDB(dst, b, h) do { _Pragma("unroll") for (int n = 0; n < 2; ++n) { if constexpr (ESZ == 2) { _Pragma("unroll") for (int k = 0; k < 2; ++k) dst[n][k] = *(const LAS bf16x8*)(ldsB + PG8_SA(b, h) + n * 2048 + k * 1024); } \
        else { dst##8[n] = __builtin_shufflevector(*(const LAS i32x4*)(ldsB + PG8_SA(b, h) + n * 2048), *(const LAS i32x4*)(ldsB + PG8_SA(b, h) + n * 2048 + 1024), 0, 1, 2, 3, 4, 5, 6, 7); } } } while (0)
#define PG8_MMA(ai, bj, At, Bt) do { __builtin_amdgcn_s_setprio(1); _Pragma("unroll") for (int m = 0; m < 4; ++m) _Pragma("unroll") for (int n = 0; n < 2; ++n) { if constexpr (ESZ == 2) { _Pragma("unroll") for (int k = 0; k < 2; ++k) \
        acc[ai][bj][m][n] = __builtin_amdgcn_mfma_f32_16x16x32_bf16(Bt[n][k], At[m][k], acc[ai][bj][m][n], 0, 0, 0); } else { \
        acc[ai][bj][m][n] = __builtin_amdgcn_mfma_scale_f32_16x16x128_f8f6f4(Bt##8[n], At##8[m], acc[ai][bj][m][n], 0, 0, 0, 0x7B7B7B7B, 0, 0x7F7F7F7F); } } __builtin_amdgcn_s_setprio(0); } while (0)
#define PG8_WAIT_V(n) asm volatile("s_waitcnt vmcnt(" #n ")" ::: "memory")
#define PG8_WAIT_L(n) asm volatile("s_waitcnt lgkmcnt(" #n ")" ::: "memory")
#define PG8_BAR __builtin_amdgcn_s_barrier()
#define PG8_SCHED __builtin_amdgcn_sched_barrier(0)
#define PG8_AOFFS(dst, u) do { int _t = tid; asm volatile("" : "+v"(_t)); _Pragma("unroll") for (int _i = 0; _i < 2; ++_i) { int _R, _C; stage_rc(_t * 16 + _i * 8192, _R, _C); \
        _Pragma("unroll") for (int _h = 0; _h < 2; ++_h) { const int _tk = S.row_tok(u, _h * HALF + _R); dst[_h][_i] = (unsigned)(_tk * K + _C) * 2u; } } } while (0)
#define PG8_AOFFS_LDS(dst, u) do { int _t = tid; asm volatile("" : "+v"(_t)); _Pragma("unroll") for (int _i = 0; _i < 2; ++_i) { int _R, _C; stage_rc(_t * 16 + _i * 8192, _R, _C); \
        _Pragma("unroll") for (int _h = 0; _h < 2; ++_h) { const int _tk = S.row_tok_lds(u, _h * HALF + _R, toktab); dst[_h][_i] = (unsigned)(_tk * K + _C) * 2u; } } } while (0)
#define PG8_STAGE_A(bufoff, p, h) do { if constexpr (Sched::GATHER) { PG8_STAGE(bufoff, p, ao[h]); } else { PG8_STAGE(bufoff, (p) + (h) * hstep, voffA); } } while (0)
#define PG8_ABASE(u) (Sched::GATHER ? (const char*)Aptr : (const char*)Aptr + (size_t)(u).pm * tstep)
    Unit cur, nxt; int ui = 0;
    if (!S.next(0, cur)) return;
    LAS int* toktab = (LAS int*)(lds + TOKTAB_OFF);
    f32x4 acc[2][2][4][2];
    E.init(acc, cur, wc, fq);
    bf16x8 At[4][2], B0[2][2], B1[2][2]; i32x8 At8[4], B08[2], B18[2];
    unsigned ao[2][2];
    if constexpr (Sched::GATHER) { PG8_AOFFS(ao, cur); }
    const char* cA = PG8_ABASE(cur); const char* cB = (const char*)Btptr + (size_t)cur.pn * tstep;
    PG8_STAGE(PG8_SB(0, 0), cB, voffB); PG8_STAGE(PG8_SB(0, 1), cB + hstep, voffB); PG8_STAGE_A(PG8_SA(0, 0), cA, 0); PG8_STAGE_A(PG8_SA(0, 1), cA, 1);
    if (wr == 1) PG8_BAR;
    PG8_WAIT_V(2); PG8_BAR;
    PG8_STAGE(PG8_SB(1, 0), cB + kstep, voffB); PG8_STAGE_A(PG8_SA(1, 0), cA + kstep, 0); PG8_STAGE(PG8_SB(1, 1), cB + hstep + kstep, voffB);
    PG8_WAIT_V(6); PG8_BAR;
    for (;;) {
        const bool has_next = S.next(ui + 1, nxt);
        const char* nA = has_next ? PG8_ABASE(nxt) : cA; const char* nB = has_next ? (const char*)Btptr + (size_t)nxt.pn * tstep : cB;
        if constexpr (Sched::GATHER && Sched::TABLE) { if (has_next && wid < 4)
            __builtin_amdgcn_global_load_lds((const unsigned*)(S.tok_src(nxt) + wid * 64 + lane), (LAS unsigned*)(toktab + wid * 64), 4, 0, 0); }
#pragma nounroll
        for (int t = 0; t < nt; t += 2) {
            const bool last = (t == nt - 2);
            const char* a1 = cA + (size_t)(t + 1) * kstep;
            const char* a2 = last ? nA : cA + (size_t)(t + 2) * kstep; const char* b2 = last ? nB : cB + (size_t)(t + 2) * kstep;
            const char* a3 = a2 + kstep; const char* b3 = b2 + kstep;
            PG8_LDB(B0, 0, 0); PG8_LDB(B1, 0, 1); PG8_SCHED; PG8_LDA(At, 0, 0); PG8_STAGE_A(PG8_SA(1, 1), a1, 1);
            if constexpr (Sched::GATHER) { if (last && has_next) { PG8_AOFFS_LDS(ao, nxt); } }
            PG8_WAIT_V(8); PG8_WAIT_L(0); PG8_BAR; PG8_MMA(0, 0, At, B0); PG8_MMA(0, 1, At, B1); PG8_BAR; PG8_SCHED;
            PG8_LDA(At, 0, 1); PG8_STAGE(PG8_SB(0, 0), b2, voffB); PG8_STAGE(PG8_SB(0, 1), b2 + hstep, voffB); PG8_STAGE_A(PG8_SA(0, 0), a2, 0);
            PG8_WAIT_V(8); PG8_WAIT_L(0); PG8_BAR; PG8_MMA(1, 0, At, B0); PG8_MMA(1, 1, At, B1); PG8_BAR; PG8_SCHED;
            PG8_LDB(B0, 1, 0); PG8_LDB(B1, 1, 1); PG8_SCHED; PG8_LDA(At, 1, 0); PG8_STAGE_A(PG8_SA(0, 1), a2, 1);
            PG8_WAIT_V(8); PG8_WAIT_L(0); PG8_BAR; PG8_MMA(0, 0, At, B0); PG8_MMA(0, 1, At, B1); PG8_BAR; PG8_SCHED;
            PG8_LDA(At, 1, 1); PG8_STAGE(PG8_SB(1, 0), b3, voffB); PG8_STAGE(PG8_SB(1, 1), b3 + hstep, voffB); PG8_STAGE_A(PG8_SA(1, 0), a3, 0);
            PG8_WAIT_V(8); PG8_WAIT_L(0); PG8_BAR; PG8_MMA(1, 0, At, B0); PG8_MMA(1, 1, At, B1); PG8_BAR; PG8_SCHED;
        }
        if constexpr (ALIGN_EPI) { if (wr == 0) PG8_BAR; }
        typename Epi::Pre pre; if (has_next) E.prefetch(pre, nxt);
        E(acc, cur, wr, wc, fr, fq);
        if (!has_next) break;
        E.init2(acc, pre);
        cur = nxt; cA = nA; cB = nB; ++ui;
        if constexpr (ALIGN_EPI) { if (wr == 1) PG8_BAR; }
    }
    PG8_WAIT_V(0);
    if constexpr (!ALIGN_EPI) { if (wr == 0) PG8_BAR; }
    PG8_BAR;
#undef PG8_SA
#undef PG8_SB
#undef PG8_STAGE
#undef PG8_LDA
#undef PG8_LDB
#undef PG8_MMA
#undef PG8_WAIT_V
#undef PG8_WAIT_L
#undef PG8_BAR
#undef PG8_SCHED
#undef PG8_AOFFS
#undef PG8_AOFFS_LDS
#undef PG8_STAGE_A
#undef PG8_ABASE
}

struct EpiConvIn {
    static constexpr bool PERM = true;
    __device__ __forceinline__ void init(f32x4 (&acc)[2][2][4][2], const Unit&, int, int) const {
#pragma unroll
        for (int a = 0; a < 2; ++a)
#pragma unroll
            for (int b = 0; b < 2; ++b)
#pragma unroll
                for (int m = 0; m < 4; ++m)
#pragma unroll
                    for (int n = 0; n < 2; ++n) acc[a][b][m][n] = (f32x4){0.f, 0.f, 0.f, 0.f};
    }
    struct Pre {};
    __device__ __forceinline__ void prefetch(Pre&, const Unit&) const {}
    __device__ __forceinline__ void init2(f32x4 (&acc)[2][2][4][2], const Pre&) const { Unit u{}; init(acc, u, 0, 0); }
    bf16_t* Bb; bf16_t* Vb;
    __device__ __forceinline__ void operator()(const f32x4 (&acc)[2][2][4][2], const Unit& u, int wr, int wc, int fr, int fq) const {
        int row0 = u.pm * BM + wr * 64 + fr; asm volatile("" : "+v"(row0));
        if (u.pn < 8) {
            const int col0 = u.pn * 128 + wc * 32 + 8 * fq;
#pragma unroll
            for (int ai = 0; ai < 2; ++ai)
#pragma unroll
                for (int m = 0; m < 4; ++m) {
                    const f32x4 v0 = acc[ai][0][m][0] * acc[ai][1][m][0], v1 = acc[ai][0][m][1] * acc[ai][1][m][1];
                    u32x4 w; w.x = cvt_pk_bf16(v0[0], v0[1]); w.y = cvt_pk_bf16(v0[2], v0[3]); w.z = cvt_pk_bf16(v1[0], v1[1]); w.w = cvt_pk_bf16(v1[2], v1[3]);
                    *(GAS u32x4*)(Vb + (size_t)(row0 + ai * HALF + m * 16) * D + col0) = w; }
        } else {
            const int col0 = (u.pn - 8) * 256 + wc * 32 + 8 * fq;
#pragma unroll
            for (int ai = 0; ai < 2; ++ai)
#pragma unroll
                for (int m = 0; m < 4; ++m)
#pragma unroll
                    for (int bj = 0; bj < 2; ++bj) {
                        const f32x4 v0 = acc[ai][bj][m][0], v1 = acc[ai][bj][m][1];
                        u32x4 w; w.x = cvt_pk_bf16(v0[0], v0[1]); w.y = cvt_pk_bf16(v0[2], v0[3]); w.z = cvt_pk_bf16(v1[0], v1[1]); w.w = cvt_pk_bf16(v1[2], v1[3]);
                        *(GAS u32x4*)(Bb + (size_t)(row0 + ai * HALF + m * 16) * D + col0 + bj * HALF) = w; }
        }
    }
};
struct EpiQKV {
    static constexpr bool PERM = true;
    __device__ __forceinline__ void init(f32x4 (&acc)[2][2][4][2], const Unit&, int, int) const {
#pragma unroll
        for (int a = 0; a < 2; ++a)
#pragma unroll
            for (int b = 0; b < 2; ++b)
#pragma unroll
                for (int m = 0; m < 4; ++m)
#pragma unroll
                    for (int n = 0; n < 2; ++n) acc[a][b][m][n] = (f32x4){0.f, 0.f, 0.f, 0.f};
    }
    struct Pre {};
    __device__ __forceinline__ void prefetch(Pre&, const Unit&) const {}
    __device__ __forceinline__ void init2(f32x4 (&acc)[2][2][4][2], const Pre&) const { Unit u{}; init(acc, u, 0, 0); }
    bf16_t* Qb; bf16_t* Kb; bf16_t* Vb; const LAS float* gains;
    __device__ __forceinline__ void operator()(const f32x4 (&acc)[2][2][4][2], const Unit& u, int wr, int wc, int fr, int fq) const {
        const int t_ = opaque_tid(), l_ = t_ & 63, w_ = __builtin_amdgcn_readfirstlane(t_ >> 6);
        wr = w_ >> 2; wc = w_ & 3; fr = l_ & 15; fq = l_ >> 4;
        const int part = u.pn >> 2, head = (u.pn & 3) * 4 + wc;
        const int row0 = u.pm * BM + wr * 64 + fr; const int col0 = head * HD + 8 * fq;
        if (part < 2) {
            const LAS float* gp = gains + part * 64;
            f32x4 gv[2][2];
#pragma unroll
            for (int bj = 0; bj < 2; ++bj)
#pragma unroll
                for (int n = 0; n < 2; ++n) gv[bj][n] = *(const LAS f32x4*)(gp + 32 * bj + 8 * fq + 4 * n);
            bf16_t* dst = part == 0 ? Qb : Kb;
#pragma unroll
            for (int ai = 0; ai < 2; ++ai)
#pragma unroll
                for (int m = 0; m < 4; ++m) {
                    float ss = 0.f;
#pragma unroll
                    for (int bj = 0; bj < 2; ++bj)
#pragma unroll
                        for (int n = 0; n < 2; ++n) { const f32x4 x = acc[ai][bj][m][n]; ss += (x[0] * x[0] + x[1] * x[1]) + (x[2] * x[2] + x[3] * x[3]); }
                    { const auto r1 = __builtin_amdgcn_permlane16_swap(__float_as_uint(ss), __float_as_uint(ss), false, false); ss = __uint_as_float(r1[0]) + __uint_as_float(r1[1]); }
                    { const auto r2 = __builtin_amdgcn_permlane32_swap(__float_as_uint(ss), __float_as_uint(ss), false, false); ss = __uint_as_float(r2[0]) + __uint_as_float(r2[1]); }
                    const float rinv = rsqrtf(ss * (1.0f / 64.0f) + EPS);
#pragma unroll
                    for (int bj = 0; bj < 2; ++bj) {
                        const f32x4 v0 = acc[ai][bj][m][0] * rinv * gv[bj][0], v1 = acc[ai][bj][m][1] * rinv * gv[bj][1];
                        u32x4 w; w.x = cvt_pk_bf16(v0[0], v0[1]); w.y = cvt_pk_bf16(v0[2], v0[3]); w.z = cvt_pk_bf16(v1[0], v1[1]); w.w = cvt_pk_bf16(v1[2], v1[3]);
                        *(GAS u32x4*)(dst + (size_t)(row0 + ai * HALF + m * 16) * D + col0 + 32 * bj) = w; }
                }
        } else {
#pragma unroll
            for (int ai = 0; ai < 2; ++ai)
#pragma unroll
                for (int m = 0; m < 4; ++m)
#pragma unroll
                    for (int bj = 0; bj < 2; ++bj) {
                        const f32x4 v0 = acc[ai][bj][m][0], v1 = acc[ai][bj][m][1];
                        u32x4 w; w.x = cvt_pk_bf16(v0[0], v0[1]); w.y = cvt_pk_bf16(v0[2], v0[3]); w.z = cvt_pk_bf16(v1[0], v1[1]); w.w = cvt_pk_bf16(v1[2], v1[3]);
                        *(GAS u32x4*)(Vb + (size_t)(row0 + ai * HALF + m * 16) * D + col0 + 32 * bj) = w; }
        }
    }
};
template <bool XF32> struct EpiResidT {
    static constexpr bool PERM = true;
    __device__ __forceinline__ void init(f32x4 (&acc)[2][2][4][2], const Unit&, int, int) const {
#pragma unroll
        for (int a = 0; a < 2; ++a)
#pragma unroll
            for (int b = 0; b < 2; ++b)
#pragma unroll
                for (int m = 0; m < 4; ++m)
#pragma unroll
                    for (int n = 0; n < 2; ++n) acc[a][b][m][n] = (f32x4){0.f, 0.f, 0.f, 0.f};
    }
    struct Pre {};
    __device__ __forceinline__ void prefetch(Pre&, const Unit&) const {}
    __device__ __forceinline__ void init2(f32x4 (&acc)[2][2][4][2], const Pre&) const { Unit u{}; init(acc, u, 0, 0); }
    const void* xin; bf16_t* xout; const float* gt;
    __device__ __forceinline__ void operator()(const f32x4 (&acc)[2][2][4][2], const Unit& u, int wr, int wc, int fr, int fq) const {
        int row0 = u.pm * BM + wr * 64 + fr; asm volatile("" : "+v"(row0)); const int col0 = u.pn * BM + wc * 32 + 8 * fq;
        const float* gp = gt + (size_t)((u.pm * BM) / SEQ) * 6144 + col0;
        f32x4 gv[2][2];
#pragma unroll
        for (int bj = 0; bj < 2; ++bj)
#pragma unroll
            for (int n = 0; n < 2; ++n) gv[bj][n] = *(const GAS f32x4*)(gp + bj * HALF + 4 * n);
#pragma unroll
        for (int ai = 0; ai < 2; ++ai) {
            f32x4 xv[4][2][2];
#pragma unroll
            for (int mm = 0; mm < 4; ++mm) { const size_t off = (size_t)(row0 + ai * HALF + mm * 16) * D + col0;
#pragma unroll
                for (int bj = 0; bj < 2; ++bj) {
                    if constexpr (XF32) { xv[mm][bj][0] = *(const GAS f32x4*)((const float*)xin + off + bj * HALF); xv[mm][bj][1] = *(const GAS f32x4*)((const float*)xin + off + bj * HALF + 4); }
                    else { const u32x4 w = *(const GAS u32x4*)((const bf16_t*)xin + off + bj * HALF);
                           xv[mm][bj][0] = (f32x4){bf_lo(w.x), bf_hi(w.x), bf_lo(w.y), bf_hi(w.y)}; xv[mm][bj][1] = (f32x4){bf_lo(w.z), bf_hi(w.z), bf_lo(w.w), bf_hi(w.w)}; } } }
#pragma unroll
            for (int mm = 0; mm < 4; ++mm) { const size_t off = (size_t)(row0 + ai * HALF + mm * 16) * D + col0;
#pragma unroll
                for (int bj = 0; bj < 2; ++bj) { const f32x4 v0 = xv[mm][bj][0] + gv[bj][0] * acc[ai][bj][mm][0], v1 = xv[mm][bj][1] + gv[bj][1] * acc[ai][bj][mm][1];
                    u32x4 w; w.x = cvt_pk_bf16(v0[0], v0[1]); w.y = cvt_pk_bf16(v0[2], v0[3]); w.z = cvt_pk_bf16(v1[0], v1[1]); w.w = cvt_pk_bf16(v1[2], v1[3]);
                    *(GAS u32x4*)(xout + off + bj * HALF) = w; } }
            asm volatile("" ::: "memory"); }
    }
};
struct EpiMoe1 {
    static constexpr bool PERM = true;
    unsigned char* act; const float* b1;
    struct Pre { f32x4 bg[2], bu[2]; };
    __device__ __forceinline__ void prefetch(Pre& p, const Unit& u) const {
        const int t_ = opaque_tid(); const int wc_ = __builtin_amdgcn_readfirstlane(t_ >> 6) & 3, fq_ = (t_ & 63) >> 4;
        const float* bp = b1 + (size_t)u.e * 2048 + u.pnl * 128 + wc_ * 32 + 8 * fq_;
#pragma unroll
        for (int n = 0; n < 2; ++n) { p.bg[n] = *(const GAS f32x4*)(bp + 4 * n); p.bu[n] = *(const GAS f32x4*)(bp + 1024 + 4 * n); }
    }
    __device__ __forceinline__ void init2(f32x4 (&acc)[2][2][4][2], const Pre& p) const {
#pragma unroll
        for (int n = 0; n < 2; ++n)
#pragma unroll
            for (int a = 0; a < 2; ++a)
#pragma unroll
                for (int m = 0; m < 4; ++m) { acc[a][0][m][n] = p.bg[n]; acc[a][1][m][n] = p.bu[n]; }
    }
    __device__ __forceinline__ void init(f32x4 (&acc)[2][2][4][2], const Unit& u, int, int) const { Pre p; prefetch(p, u); init2(acc, p); }
    __device__ __forceinline__ void operator()(const f32x4 (&acc)[2][2][4][2], const Unit& u, int wr, int wc, int fr, int fq) const {
        int row0 = u.pm * BM + wr * 64 + fr + ((fq & 1) ? 16 : 0); asm volatile("" : "+v"(row0)); const int col0 = u.pnl * 128 + wc * 32 + 8 * (fq & 2);
#pragma unroll
        for (int ai = 0; ai < 2; ++ai)
#pragma unroll
            for (int mp = 0; mp < 2; ++mp) {
                u32x2 w[2];
#pragma unroll
                for (int mm = 0; mm < 2; ++mm) { const int m = 2 * mp + mm;
                    f32x2 o[4], gh[4], p[4], d[4];
#pragma unroll
                    for (int q = 0; q < 4; ++q) { const int n = q >> 1, hh = q & 1;
                        gh[q].x = __builtin_amdgcn_fmed3f(acc[ai][0][m][n][2 * hh], -40.0f, 7.0f); gh[q].y = __builtin_amdgcn_fmed3f(acc[ai][0][m][n][2 * hh + 1], -40.0f, 7.0f);
                        f32x2 uh; uh.x = __builtin_amdgcn_fmed3f(acc[ai][1][m][n][2 * hh], -7.0f, 7.0f); uh.y = __builtin_amdgcn_fmed3f(acc[ai][1][m][n][2 * hh + 1], -7.0f, 7.0f);
                        const f32x2 t = gh[q] * (-1.702f * 1.4426950408889634f);
                        f32x2 e; e.x = __builtin_amdgcn_exp2f(t.x); e.y = __builtin_amdgcn_exp2f(t.y);
                        d[q] = e + 1.0f; p[q] = (uh + 1.0f) * gh[q]; }
#pragma unroll
                    for (int q = 0; q < 2; ++q) { const f32x2 dd = d[q] * d[q + 2];
                        f32x2 r; r.x = __builtin_amdgcn_rcpf(dd.x); r.y = __builtin_amdgcn_rcpf(dd.y);
                        o[q] = p[q] * (d[q + 2] * r); o[q + 2] = p[q + 2] * (d[q] * r); }
                    w[mm].x = cvt_pk4_fp8(o[0].x, o[0].y, o[1].x, o[1].y); w[mm].y = cvt_pk4_fp8(o[2].x, o[2].y, o[3].x, o[3].y); }
                const auto rx = __builtin_amdgcn_permlane16_swap(w[0].x, w[1].x, false, false), ry = __builtin_amdgcn_permlane16_swap(w[0].y, w[1].y, false, false);
                u32x4 v; v.x = rx[0]; v.y = ry[0]; v.z = rx[1]; v.w = ry[1];
                *(GAS u32x4*)(act + (size_t)(row0 + ai * HALF + mp * 32) * FF + col0) = v; }
    }
};
struct EpiMoe2 {
    static constexpr bool PERM = true;
    unsigned char* Y; const float* b2; const float* gl; const LAS int* tab;
    struct Pre { f32x4 bv[2][2]; };
    __device__ __forceinline__ void prefetch(Pre& p, const Unit& u) const {
        const int t_ = opaque_tid(); const int wc_ = __builtin_amdgcn_readfirstlane(t_ >> 6) & 3, fq_ = (t_ & 63) >> 4;
        const float* bp = b2 + (size_t)u.e * D + u.pnl * BM + wc_ * 32 + 8 * fq_;
#pragma unroll
        for (int bj = 0; bj < 2; ++bj)
#pragma unroll
            for (int n = 0; n < 2; ++n) p.bv[bj][n] = *(const GAS f32x4*)(bp + bj * HALF + 4 * n);
    }
    __device__ __forceinline__ void init2(f32x4 (&acc)[2][2][4][2], const Pre& p) const {
#pragma unroll
        for (int bj = 0; bj < 2; ++bj)
#pragma unroll
            for (int n = 0; n < 2; ++n)
#pragma unroll
                for (int a = 0; a < 2; ++a)
#pragma unroll
                    for (int m = 0; m < 4; ++m) acc[a][bj][m][n] = p.bv[bj][n];
    }
    __device__ __forceinline__ void init(f32x4 (&acc)[2][2][4][2], const Unit& u, int, int) const { Pre p; prefetch(p, u); init2(acc, p); }
    __device__ __forceinline__ void operator()(const f32x4 (&acc)[2][2][4][2], const Unit& u, int wr, int wc, int fr, int fq) const {
        const int t_ = opaque_tid(), l_ = t_ & 63, w_ = __builtin_amdgcn_readfirstlane(t_ >> 6);
        const int rl0 = (w_ >> 2) * 64 + (l_ & 15); const int col0 = u.pnl * BM + (w_ & 3) * 32 + 8 * ((l_ >> 4) & 2);
        unsigned char* yp = Y + (size_t)u.pm * BM * D + col0;
#pragma unroll
        for (int ai = 0; ai < 2; ++ai)
#pragma unroll
            for (int mp = 0; mp < 2; ++mp) {
                const int rl = rl0 + ai * HALF + mp * 32 + ((l_ & 16) ? 16 : 0);
#pragma unroll
                for (int bj = 0; bj < 2; ++bj) {
                    u32x2 w[2];
#pragma unroll
                    for (int mm = 0; mm < 2; ++mm) { const int m = 2 * mp + mm; const f32x4 v0 = acc[ai][bj][m][0], v1 = acc[ai][bj][m][1];
                        w[mm].x = cvt_pk4_fp8(v0[0], v0[1], v0[2], v0[3]); w[mm].y = cvt_pk4_fp8(v1[0], v1[1], v1[2], v1[3]); }
                    const auto rx = __builtin_amdgcn_permlane16_swap(w[0].x, w[1].x, false, false), ry = __builtin_amdgcn_permlane16_swap(w[0].y, w[1].y, false, false);
                    u32x4 v; v.x = rx[0]; v.y = ry[0]; v.z = rx[1]; v.w = ry[1];
                    *(GAS u32x4*)(yp + (size_t)rl * D + bj * HALF) = v; }
            }
    }
};
}

constexpr int NWAVES = 8;
struct Args {
    const float* x; const float* c; const float* norm1_g; const float* norm2_g; const float* ada_w; const float* ada_b;
    const float* conv_w_in; const float* conv_w; const float* conv_w_out; const float* attn_w_qkv; const float* attn_q_g; const float* attn_k_g; const float* attn_w_o;
    const float* router_w; const float* router_b; const float* moe_w1; const float* moe_b1; const float* moe_w2; const float* moe_b2;
    float* out; unsigned char* ws;
};

__device__ __forceinline__ void transpose_item(const float* W, int K, int N, bf16_t* WT, int d0, int n0, int kb, LAS float* scr, int lane) {
    const int k0 = 64 * kb;
    float wv[32];
#pragma unroll
    for (int i = 0; i < 32; ++i) wv[i] = __builtin_nontemporal_load(W + (size_t)(k0 + 2 * i + (lane >> 5)) * N + n0 + (lane & 31));
#pragma unroll
    for (int i = 0; i < 32; ++i) scr[(2 * i + (lane >> 5)) * 33 + (lane & 31)] = wv[i];
    LDS_WAIT(); asm volatile("" ::: "memory");
    const int c = lane & 7;
#pragma unroll
    for (int j = 0; j < 4; ++j) { const int n = (lane >> 3) + 8 * j; const LAS float* s = scr + (8 * c) * 33 + n;
        u32x4 o; o.x = cvt_pk_bf16(s[0 * 33], s[1 * 33]); o.y = cvt_pk_bf16(s[2 * 33], s[3 * 33]); o.z = cvt_pk_bf16(s[4 * 33], s[5 * 33]); o.w = cvt_pk_bf16(s[6 * 33], s[7 * 33]);
        __builtin_nontemporal_store(o, (GAS u32x4*)(WT + (size_t)(d0 + n) * K + k0 + 8 * c)); }
    LDS_WAIT(); asm volatile("" ::: "memory");
}
__device__ __forceinline__ void transpose_item_fp8(const float* W, int K, int N, unsigned char* WT, int d0, int n0, int kb, LAS float* scr, int lane) {
    const int k0 = 64 * kb;
    float wv[32];
#pragma unroll
    for (int i = 0; i < 32; ++i) wv[i] = __builtin_nontemporal_load(W + (size_t)(k0 + 2 * i + (lane >> 5)) * N + n0 + (lane & 31));
#pragma unroll
    for (int i = 0; i < 32; ++i) scr[(2 * i + (lane >> 5)) * 33 + (lane & 31)] = wv[i] * 16.0f;
    LDS_WAIT(); asm volatile("" ::: "memory");
    const int c = lane & 7;
#pragma unroll
    for (int j = 0; j < 4; ++j) { const int n = (lane >> 3) + 8 * j; const LAS float* s = scr + (8 * c) * 33 + n;
        u32x2 o; o.x = cvt_pk4_fp8(s[0 * 33], s[1 * 33], s[2 * 33], s[3 * 33]); o.y = cvt_pk4_fp8(s[4 * 33], s[5 * 33], s[6 * 33], s[7 * 33]);
        __builtin_nontemporal_store(o, (GAS u32x2*)(WT + (size_t)(d0 + n) * K + k0 + 8 * c)); }
    LDS_WAIT(); asm volatile("" ::: "memory");
}
__device__ __forceinline__ int src_convin(int g) { if (g < 64) { const int t = g >> 3, bj = (g & 7) >> 2, jj = g & 3; return (1 + bj) * 1024 + 128 * t + 32 * jj; } return 32 * (g - 64); }
__device__ __forceinline__ int src_qkv(int g) { const int pn = g >> 3, bj = (g & 7) >> 2, wc = g & 3; return (pn >> 2) * 1024 + ((pn & 3) * 4 + wc) * 64 + 32 * bj; }
__device__ __forceinline__ int src_w1(int g) { const int pn = g >> 3, bj = (g & 7) >> 2, jj = g & 3; return bj * 1024 + 128 * pn + 32 * jj; }

struct PItem { const float* src; unsigned char* dst; int N, K, fp8; };
__device__ __forceinline__ void prologue(const Args& a, LAS unsigned char* lds, int vcu, int G) {
    const int tid = opaque_tid(), lane = tid & 63, wave = __builtin_amdgcn_readfirstlane(tid >> 6);
    unsigned char* ws = a.ws;
    {
        LAS float* cact = (LAS float*)lds;
        LAS float* red = (LAS float*)(lds + 65536);
        for (int i = tid; i < NB * D; i += NWAVES * 64) { const float v = a.c[i]; cact[i] = v / (1.0f + __expf(-v)); }
        __syncthreads();
        float* mod = (float*)(ws + WS_MOD);
        constexpr int NITEM = DEPTH * 6144 / 64;
        for (int it = vcu; it < NITEM; it += G) {
            const int l = it / 96, j0 = (it % 96) * 64;
            const float* wp = a.ada_w + (size_t)l * D * 6144 + (size_t)(128 * wave) * 6144 + j0 + lane;
            float accv[16];
#pragma unroll
            for (int b = 0; b < 16; ++b) accv[b] = 0.f;
            const float* wb = (const float*)opaque_ptr((unsigned char*)(a.ada_w + (size_t)l * D * 6144 + (size_t)(128 * wave) * 6144 + j0));
#pragma nounroll
            for (int d16 = 0; d16 < 8; ++d16) {
                float w16[16];
#pragma unroll
                for (int q = 0; q < 16; ++q) w16[q] = __builtin_nontemporal_load((const GAS float*)wb + (size_t)(16 * d16 + q) * 6144 + lane);
#pragma unroll
                for (int q4 = 0; q4 < 4; ++q4)
#pragma unroll
                    for (int b = 0; b < 16; ++b) { const f32x4 cv = *(const LAS f32x4*)(cact + b * D + 128 * wave + 16 * d16 + 4 * q4);
                        accv[b] += cv[0] * w16[4 * q4] + cv[1] * w16[4 * q4 + 1] + cv[2] * w16[4 * q4 + 2] + cv[3] * w16[4 * q4 + 3]; }
            }
#pragma unroll
            for (int b = 0; b < 16; ++b) red[(wave * 16 + b) * 64 + lane] = accv[b];
            __syncthreads();
            for (int o = tid; o < 16 * 64; o += NWAVES * 64) { const int b = o >> 6, j = o & 63; float s = a.ada_b[l * 6144 + j0 + j];
#pragma unroll
                for (int w = 0; w < 8; ++w) s += red[(w * 16 + b) * 64 + j];
                ((GAS float*)mod)[((size_t)l * NB + b) * 6144 + j0 + j] = s; }
            __syncthreads();
        }
    }
    {
        LAS float* scr = (LAS float*)(lds + wave * 16384);
        const int gw = vcu * NWAVES + wave, NGW = G * NWAVES;
        constexpr int I_CIN = 96 * 16, I_SQ = 32 * 16, I_R = 16, I_W1 = 64 * 16, I_W2 = 32 * 16;
        constexpr int N_SMALL = 2 * I_CIN + 2 * I_SQ + 2 * I_CIN + 2 * I_SQ + 4 * I_R;
        constexpr int N_W1 = DEPTH * NE * I_W1, N_W2 = DEPTH * NE * I_W2;
        constexpr int NITEMS = N_SMALL + N_W1 + N_W2;
        auto decode = [&](int it) -> PItem {
            const float* W; unsigned char* WT; int K, N, d0, n0, kb, f8;
            int r = it;
            if (r < N_SMALL) {
                if (r < 2 * I_CIN) { const int j = r / I_CIN, q = r % I_CIN, g = q >> 4; kb = q & 15; W = a.conv_w_in + (size_t)j * D * 3072; K = D; N = 3072; WT = ws + WS_WCIN + (size_t)j * 3072 * D * 2; d0 = 32 * g; n0 = src_convin(g); f8 = 0; }
                else if ((r -= 2 * I_CIN) < 2 * I_SQ) { const int j = r / I_SQ, q = r % I_SQ, g = q >> 4; kb = q & 15; W = a.conv_w_out + (size_t)j * D * D; K = D; N = D; WT = ws + WS_WCOUT + (size_t)j * D * D; d0 = 32 * g; n0 = 32 * g; f8 = 1; }
                else if ((r -= 2 * I_SQ) < 2 * I_CIN) { const int j = r / I_CIN, q = r % I_CIN, g = q >> 4; kb = q & 15; W = a.attn_w_qkv + (size_t)j * D * 3072; K = D; N = 3072; WT = ws + WS_WQKV + (size_t)j * 3072 * D; d0 = 32 * g; n0 = src_qkv(g); f8 = 1; }
                else if ((r -= 2 * I_CIN) < 2 * I_SQ) { const int j = r / I_SQ, q = r % I_SQ, g = q >> 4; kb = q & 15; W = a.attn_w_o + (size_t)j * D * D; K = D; N = D; WT = ws + WS_WO + (size_t)j * D * D; d0 = 32 * g; n0 = 32 * g; f8 = 1; }
                else { r -= 2 * I_SQ; const int l = r / I_R; kb = r % I_R; W = a.router_w + (size_t)l * D * NE; K = D; N = NE; WT = ws + WS_WR + (size_t)l * NE * D * 2; d0 = 0; n0 = 0; f8 = 0; }
            } else if ((r -= N_SMALL) < N_W1) { const int mtx = r / I_W1, q = r % I_W1, g = q >> 4; kb = q & 15; W = a.moe_w1 + (size_t)mtx * D * 2048; K = D; N = 2048; WT = ws + WS_W1 + (size_t)mtx * 2048 * D; d0 = 32 * g; n0 = src_w1(g); f8 = 1; }
            else { r -= N_W1; const int mtx = r / I_W2, q = r % I_W2, g = q >> 4; kb = q & 15; W = a.moe_w2 + (size_t)mtx * FF * D; K = FF; N = D; WT = ws + WS_W2 + (size_t)mtx * D * FF; d0 = 32 * g; n0 = 32 * g; f8 = 1; }
            PItem p; p.src = W + (size_t)(64 * kb) * N + n0; p.dst = WT + ((size_t)d0 * K + 64 * kb) * (f8 ? 1 : 2); p.N = N; p.K = K; p.fp8 = f8; return p;
        };
        if (gw < NITEMS) {
            int it = gw;
            PItem cur = decode(it);
            float wvA[32];
#pragma unroll
            for (int i = 0; i < 32; ++i) wvA[i] = __builtin_nontemporal_load((const GAS float*)cur.src + (size_t)(2 * i + (lane >> 5)) * cur.N + (lane & 31));
#pragma nounroll
            for (;;) {
                const int itn = it + NGW; const bool has = itn < NITEMS;
                const PItem nx = decode(has ? itn : it);
                float wvB[32];
#pragma unroll
                for (int i = 0; i < 32; ++i) wvB[i] = __builtin_nontemporal_load((const GAS float*)nx.src + (size_t)(2 * i + (lane >> 5)) * nx.N + (lane & 31));
                const float sc = cur.fp8 ? 16.0f : 1.0f;
#pragma unroll
                for (int i = 0; i < 32; ++i) scr[(2 * i + (lane >> 5)) * 33 + (lane & 31)] = wvA[i] * sc;
                LDS_WAIT(); asm volatile("" ::: "memory");
                const int c = lane & 7;
#pragma unroll
                for (int j = 0; j < 4; ++j) { const int n = (lane >> 3) + 8 * j; const LAS float* sp_ = scr + (8 * c) * 33 + n;
                    if (cur.fp8) { u32x2 o; o.x = cvt_pk4_fp8(sp_[0 * 33], sp_[1 * 33], sp_[2 * 33], sp_[3 * 33]); o.y = cvt_pk4_fp8(sp_[4 * 33], sp_[5 * 33], sp_[6 * 33], sp_[7 * 33]);
                        __builtin_nontemporal_store(o, (GAS u32x2*)(cur.dst + (size_t)n * cur.K + 8 * c)); }
                    else { u32x4 o; o.x = cvt_pk_bf16(sp_[0 * 33], sp_[1 * 33]); o.y = cvt_pk_bf16(sp_[2 * 33], sp_[3 * 33]); o.z = cvt_pk_bf16(sp_[4 * 33], sp_[5 * 33]); o.w = cvt_pk_bf16(sp_[6 * 33], sp_[7 * 33]);
                        __builtin_nontemporal_store(o, (GAS u32x4*)(cur.dst + ((size_t)n * cur.K + 8 * c) * 2)); } }
                LDS_WAIT(); asm volatile("" ::: "memory");
                if (!has) break;
                cur = nx; it = itn;
#pragma unroll
                for (int i = 0; i < 32; ++i) wvA[i] = wvB[i];
            }
        }
    }
}

__device__ __forceinline__ void norm_phase(const float* __restrict__ x, const float* g, const float* modl  , int shoff, int scoff, bf16_t* __restrict__ h, unsigned char* __restrict__ h8, int vcu, int G) {
    const int tid = opaque_tid(), lane = tid & 63, gw = vcu * NWAVES + __builtin_amdgcn_readfirstlane(tid >> 6), NGW = G * NWAVES;
    for (int w = gw; w < NTOK / 32; w += NGW) {
        const int row0 = w * 32, b = row0 / SEQ;
        const float* sc = modl + (size_t)b * 6144 + scoff; const float* sh = modl + (size_t)b * 6144 + shoff;
        f32x4 av[4], sv[4];
#pragma unroll
        for (int j = 0; j < 4; ++j) { const int cidx = 4 * lane + 256 * j; av[j] = *(const GAS f32x4*)(g + cidx) * (*(const GAS f32x4*)(sc + cidx) + 1.0f); sv[j] = *(const GAS f32x4*)(sh + cidx); }
#pragma nounroll
        for (int r = 0; r < 32; r += 4) {
            f32x4 v[4][4];
#pragma unroll
            for (int q = 0; q < 4; ++q) { const GAS f32x4* xr = (const GAS f32x4*)(x + (size_t)(row0 + r + q) * D) + lane;
#pragma unroll
                for (int j = 0; j < 4; ++j) v[q][j] = xr[64 * j]; }
#pragma unroll
            for (int q = 0; q < 4; ++q) {
                float s = 0.f;
#pragma unroll
                for (int j = 0; j < 4; ++j) s += (v[q][j].x * v[q][j].x + v[q][j].y * v[q][j].y) + (v[q][j].z * v[q][j].z + v[q][j].w * v[q][j].w);
                const float rinv = rsqrtf(wave_sum(s) * (1.0f / D) + EPS);
                GAS u32x2* o8 = (GAS u32x2*)(h + (size_t)(row0 + r + q) * D) + lane; GAS unsigned* o4 = (GAS unsigned*)(h8 + (size_t)(row0 + r + q) * D) + lane;
#pragma unroll
                for (int j = 0; j < 4; ++j) { const f32x4 y = v[q][j] * rinv * av[j] + sv[j]; u32x2 w2; w2.x = cvt_pk_bf16(y.x, y.y); w2.y = cvt_pk_bf16(y.z, y.w); o8[64 * j] = w2; if (h8) o4[64 * j] = cvt_pk4_fp8(y.x, y.y, y.z, y.w); }
            }
        }
    }
}
__device__ __forceinline__ void conv_phase(const bf16_t* __restrict__ Bb, const bf16_t* __restrict__ Vb, const float* cw  , unsigned char* __restrict__ Zb, int vcu, int G) {
    const int tid = opaque_tid();
    const int cg = tid & 127, sub = tid >> 7, c0 = cg * 8;
    float w0[8], w1[8], w2[8];
#pragma unroll
    for (int i = 0; i < 8; ++i) { w0[i] = cw[c0 + i]; w1[i] = cw[D + c0 + i]; w2[i] = cw[2 * D + c0 + i]; }
    for (int blk = vcu; blk < NTOK / 256; blk += G) {
        const int t0 = blk * 256 + sub * 64;
        float p1[8], p2[8];
        if ((t0 % SEQ) == 0) {
#pragma unroll
            for (int i = 0; i < 8; ++i) { p1[i] = 0.f; p2[i] = 0.f; }
        } else {
            const u32x4 a1 = *(const GAS u32x4*)(Vb + (size_t)(t0 - 1) * D + c0), a2 = *(const GAS u32x4*)(Vb + (size_t)(t0 - 2) * D + c0);
            p1[0] = bf_lo(a1.x); p1[1] = bf_hi(a1.x); p1[2] = bf_lo(a1.y); p1[3] = bf_hi(a1.y); p1[4] = bf_lo(a1.z); p1[5] = bf_hi(a1.z); p1[6] = bf_lo(a1.w); p1[7] = bf_hi(a1.w);
            p2[0] = bf_lo(a2.x); p2[1] = bf_hi(a2.x); p2[2] = bf_lo(a2.y); p2[3] = bf_hi(a2.y); p2[4] = bf_lo(a2.z); p2[5] = bf_hi(a2.z); p2[6] = bf_lo(a2.w); p2[7] = bf_hi(a2.w);
        }
#pragma nounroll
        for (int t = t0; t < t0 + 64; t += 4) {
            u32x4 vv4[4], bb4[4];
#pragma unroll
            for (int q = 0; q < 4; ++q) { vv4[q] = __builtin_nontemporal_load((const GAS u32x4*)(Vb + (size_t)(t + q) * D + c0)); bb4[q] = __builtin_nontemporal_load((const GAS u32x4*)(Bb + (size_t)(t + q) * D + c0)); }
#pragma unroll
            for (int q = 0; q < 4; ++q) {
                const u32x4 vv = vv4[q], bb = bb4[q];
                float v[8], bg[8], z[8];
                v[0] = bf_lo(vv.x); v[1] = bf_hi(vv.x); v[2] = bf_lo(vv.y); v[3] = bf_hi(vv.y); v[4] = bf_lo(vv.z); v[5] = bf_hi(vv.z); v[6] = bf_lo(vv.w); v[7] = bf_hi(vv.w);
                bg[0] = bf_lo(bb.x); bg[1] = bf_hi(bb.x); bg[2] = bf_lo(bb.y); bg[3] = bf_hi(bb.y); bg[4] = bf_lo(bb.z); bg[5] = bf_hi(bb.z); bg[6] = bf_lo(bb.w); bg[7] = bf_hi(bb.w);
#pragma unroll
                for (int i = 0; i < 8; ++i) { z[i] = bg[i] * (w2[i] * v[i] + w1[i] * p1[i] + w0[i] * p2[i]); p2[i] = p1[i]; p1[i] = v[i]; }
#pragma unroll
                for (int i = 0; i < 8; ++i) z[i] = __builtin_amdgcn_fmed3f(z[i], -448.0f, 448.0f);
                u32x2 o; o.x = cvt_pk4_fp8(z[0], z[1], z[2], z[3]); o.y = cvt_pk4_fp8(z[4], z[5], z[6], z[7]);
                *(GAS u32x2*)(Zb + (size_t)(t + q) * D + c0) = o;
            }
        }
    }
}

constexpr int AK_STRIDE = 144, AV_STRIDE = 192;
constexpr int AK_OFF = 0, AK_BUF = 64 * AK_STRIDE, AV_OFF = 2 * AK_BUF, AV_BUF = 64 * AV_STRIDE;
constexpr int AF_OFF = AV_OFF + 2 * AV_BUF;
constexpr float ATT_RDONE = 5.9604645e-08f;
__device__ __forceinline__ s16x4 vtr(const LAS unsigned char* p) { return __builtin_bit_cast(s16x4, __builtin_amdgcn_ds_read_tr16_b64_v4i16((LAS s16x4*)p)); }
__device__ __forceinline__ void attn_unit(LAS unsigned char* lds, const bf16_t* Q, const bf16_t* Kg, const bf16_t* Vg, bf16_t* O, int b, int h, int qb) {
    const int tid = opaque_tid(), lane = tid & 63, wid = __builtin_amdgcn_readfirstlane(tid >> 6), r32 = lane & 31, hi = lane >> 5;
    const size_t rowbase = (size_t)b * SEQ;
    const int Tq0 = qb * 256, tq = Tq0 + 32 * wid + r32;
    bf16x8 qf[4];
    { const bf16_t* qp = Q + (rowbase + tq) * D + h * HD + hi * 8;
#pragma unroll
      for (int d0 = 0; d0 < 4; ++d0) qf[d0] = *(const GAS bf16x8*)(qp + 16 * d0); }
    f32x16 o0, o1;
#pragma unroll
    for (int r = 0; r < 16; ++r) { o0[r] = 0.f; o1[r] = 0.f; }
    float R = 1.0f; bool wdone = false;
    LAS int* dflag = (LAS int*)(lds + AF_OFF);
    const int NT = 4 * qb + 4, jw = 4 * qb + (wid >> 1);
    const int srow = tid >> 3, sch = tid & 7;
    const bf16_t* kgp = Kg + (rowbase + srow) * D + h * HD + sch * 8;
    const bf16_t* vgp = Vg + (rowbase + srow) * D + h * HD + sch * 8;
    LAS unsigned char* kst = lds + AK_OFF + srow * AK_STRIDE + sch * 16;
    LAS unsigned char* vst = lds + AV_OFF + srow * AV_STRIDE + sch * 16;
    u32x4 kreg = *(const GAS u32x4*)(kgp + (size_t)(NT - 1) * 64 * D), vreg = *(const GAS u32x4*)(vgp + (size_t)(NT - 1) * 64 * D);
    *(LAS u32x4*)(kst + ((NT - 1) & 1) * AK_BUF) = kreg; *(LAS u32x4*)(vst + ((NT - 1) & 1) * AV_BUF) = vreg;
    __syncthreads();
    const int kr0 = 32 * ((r32 >> 2) & 1) + (r32 & 3) + 4 * (r32 >> 3);
    const int kread = kr0 * AK_STRIDE + hi * 16;
    const int vread = (32 * hi + ((lane & 15) >> 2)) * AV_STRIDE + (16 * ((lane >> 4) & 1) + 4 * (lane & 3)) * 2;
    for (int j = NT - 1; j >= 0; --j) {
        const int buf = j & 1;
        if (j > 0) { kreg = *(const GAS u32x4*)(kgp + (size_t)(j - 1) * 64 * D); vreg = *(const GAS u32x4*)(vgp + (size_t)(j - 1) * 64 * D); }
        if (j <= jw && !wdone) {
            const LAS unsigned char* Kb = lds + AK_OFF + buf * AK_BUF + kread;
            f32x16 p0, p1;
#pragma unroll
            for (int r = 0; r < 16; ++r) { p0[r] = 0.f; p1[r] = 0.f; }
#pragma unroll
            for (int d0 = 0; d0 < 4; ++d0) {
                const bf16x8 k0 = *(const LAS bf16x8*)(Kb + d0 * 32), k1 = *(const LAS bf16x8*)(Kb + 16 * AK_STRIDE + d0 * 32);
                p0 = __builtin_amdgcn_mfma_f32_32x32x16_bf16(k0, qf[d0], p0, 0, 0, 0);
                p1 = __builtin_amdgcn_mfma_f32_32x32x16_bf16(k1, qf[d0], p1, 0, 0, 0);
            }
            const int kb0 = 64 * j + 32 * hi;
            const bool partial = (j == jw);
#pragma unroll
            for (int r = 0; r < 16; ++r) {
                float e0 = __builtin_amdgcn_exp2f(p0[r]), e1 = __builtin_amdgcn_exp2f(p1[r]);
                if (partial) { if (kb0 + r >= tq) e0 = 0.f; if (kb0 + 16 + r >= tq) e1 = 0.f; }
                p0[r] = __builtin_amdgcn_rcpf(1.0f + e0); p1[r] = __builtin_amdgcn_rcpf(1.0f + e1);
            }
            float l = 1.0f;
#pragma unroll
            for (int r = 15; r >= 0; --r) { const float ln = l * p1[r]; p1[r] = l - ln; l = ln; }
#pragma unroll
            for (int r = 15; r >= 0; --r) { const float ln = l * p0[r]; p0[r] = l - ln; l = ln; }
            float T0, T1;
            { auto rr = __builtin_amdgcn_permlane32_swap(__float_as_uint(l), __float_as_uint(l), false, false); T0 = __uint_as_float(rr[0]); T1 = __uint_as_float(rr[1]); }
            const float pre = hi ? R : R * T1;
            R = R * T1 * T0;
            u32x4 pa[4];
#pragma unroll
            for (int q = 0; q < 4; ++q) { pa[0][q] = cvt_pk_bf16(p0[2 * q] * pre, p0[2 * q + 1] * pre); pa[1][q] = cvt_pk_bf16(p0[8 + 2 * q] * pre, p0[9 + 2 * q] * pre);
                                          pa[2][q] = cvt_pk_bf16(p1[2 * q] * pre, p1[2 * q + 1] * pre); pa[3][q] = cvt_pk_bf16(p1[8 + 2 * q] * pre, p1[9 + 2 * q] * pre); }
            const LAS unsigned char* Vb = lds + AV_OFF + buf * AV_BUF + vread;
#pragma unroll
            for (int m = 0; m < 4; ++m) {
                const s16x4 a0 = vtr(Vb + (8 * m) * AV_STRIDE), a1 = vtr(Vb + (8 * m + 4) * AV_STRIDE);
                const s16x4 c0 = vtr(Vb + (8 * m) * AV_STRIDE + 64), c1 = vtr(Vb + (8 * m + 4) * AV_STRIDE + 64);
                const bf16x8 v0 = (bf16x8){a0[0], a0[1], a0[2], a0[3], a1[0], a1[1], a1[2], a1[3]};
                const bf16x8 v1 = (bf16x8){c0[0], c0[1], c0[2], c0[3], c1[0], c1[1], c1[2], c1[3]};
                const bf16x8 pf = __builtin_bit_cast(bf16x8, pa[m]);
                o0 = __builtin_amdgcn_mfma_f32_32x32x16_bf16(pf, v0, o0, 0, 0, 0);
                o1 = __builtin_amdgcn_mfma_f32_32x32x16_bf16(pf, v1, o1, 0, 0, 0);
            }
        }
        if (j > 0) { *(LAS u32x4*)(kst + (buf ^ 1) * AK_BUF) = kreg; *(LAS u32x4*)(vst + (buf ^ 1) * AV_BUF) = vreg; }
        wdone = (j <= jw) && __all(R < ATT_RDONE);
        if (lane == 0) dflag[buf * 8 + wid] = wdone ? 1 : 0;
        __syncthreads();
        { const i32x4 f0 = *(const LAS i32x4*)(dflag + buf * 8), f1 = *(const LAS i32x4*)(dflag + buf * 8 + 4);
          if ((f0[0] & f0[1] & f0[2] & f0[3] & f1[0] & f1[1] & f1[2] & f1[3]) != 0) break; }
    }
    __syncthreads();
    bf16_t* Ow = O + (rowbase + Tq0 + 32 * wid) * D + h * HD + r32;
#pragma unroll
    for (int r = 0; r < 16; ++r) { const int q = (r & 3) + 8 * (r >> 2) + 4 * hi;
        ((GAS bf16_t*)Ow)[(size_t)q * D] = (bf16_t)(cvt_pk_bf16(o0[r], 0.f) & 0xffffu); ((GAS bf16_t*)Ow)[(size_t)q * D + 32] = (bf16_t)(cvt_pk_bf16(o1[r], 0.f) & 0xffffu); }
}

constexpr int AP_K = 64 * AK_STRIDE, AP_V = 64 * AV_STRIDE, AP_PAIR = AP_K + AP_V, AP_FLAG = 4 * AP_PAIR;
__device__ __forceinline__ void attn_unit_pairs(LAS unsigned char* lds, const bf16_t* Q, const bf16_t* Kg, const bf16_t* Vg, bf16_t* O, int b, int h, int qb, int& par, int& psn) {
    const int tid = opaque_tid(), lane = tid & 63, wid = __builtin_amdgcn_readfirstlane(tid >> 6), r32 = lane & 31, hi = lane >> 5;
    const int pair = wid >> 1, ptid = (wid & 1) * 64 + lane;
    const size_t rowbase = (size_t)b * SEQ;
    const int Tq0 = qb * 256, tq = Tq0 + 32 * wid + r32;
    bf16x8 qf[4];
    { const bf16_t* qp = Q + (rowbase + tq) * D + h * HD + hi * 8;
#pragma unroll
      for (int d0 = 0; d0 < 4; ++d0) qf[d0] = *(const GAS bf16x8*)(qp + 16 * d0); }
    f32x16 o0, o1;
#pragma unroll
    for (int r = 0; r < 16; ++r) { o0[r] = 0.f; o1[r] = 0.f; }
    float R = 1.0f;
    LAS int* dflag = (LAS int*)(lds + AP_FLAG);
    LAS int* pcnt = (LAS int*)(lds + AP_FLAG + 256) + pair * 16;
#define PAIR_SYNC() do { asm volatile("s_waitcnt lgkmcnt(0)" ::: "memory"); psn += 2; \
        if (lane == 0) (void)__hip_atomic_fetch_add(pcnt, 1, __ATOMIC_RELAXED, __HIP_MEMORY_SCOPE_WORKGROUP); \
        { int _sp = 0; while (__hip_atomic_load(pcnt, __ATOMIC_RELAXED, __HIP_MEMORY_SCOPE_WORKGROUP) < psn && ++_sp < (1 << 24)) __builtin_amdgcn_s_sleep(0); } \
        asm volatile("" ::: "memory"); } while (0)
    const int jw = 4 * qb + pair;
    LAS unsigned char* Kl = lds + pair * AP_PAIR; LAS unsigned char* Vl = Kl + AP_K;
    const int srow = ptid >> 3, sch = ptid & 7;
    const bf16_t* kgp = Kg + (rowbase + srow) * D + h * HD + sch * 8;
    const bf16_t* vgp = Vg + (rowbase + srow) * D + h * HD + sch * 8;
    LAS unsigned char* kst = Kl + srow * AK_STRIDE + sch * 16; LAS unsigned char* vst = Vl + srow * AV_STRIDE + sch * 16;
    u32x4 kreg[4], vreg[4];
#pragma unroll
    for (int i = 0; i < 4; ++i) { kreg[i] = *(const GAS u32x4*)(kgp + (size_t)(64 * jw + 16 * i) * D); vreg[i] = *(const GAS u32x4*)(vgp + (size_t)(64 * jw + 16 * i) * D); }
#pragma unroll
    for (int i = 0; i < 4; ++i) { *(LAS u32x4*)(kst + 16 * i * AK_STRIDE) = kreg[i]; *(LAS u32x4*)(vst + 16 * i * AV_STRIDE) = vreg[i]; }
    PAIR_SYNC();
    const int kr0 = 32 * ((r32 >> 2) & 1) + (r32 & 3) + 4 * (r32 >> 3);
    const int kread = kr0 * AK_STRIDE + hi * 16;
    const int vread = (32 * hi + ((lane & 15) >> 2)) * AV_STRIDE + (16 * ((lane >> 4) & 1) + 4 * (lane & 3)) * 2;
    bool w_act = true;
    for (int j = jw; ; --j) {
        const bool pf = j > 0 && j == jw;
        if (pf) {
#pragma unroll
            for (int i = 0; i < 4; ++i) { kreg[i] = *(const GAS u32x4*)(kgp + (size_t)(64 * (j - 1) + 16 * i) * D); vreg[i] = *(const GAS u32x4*)(vgp + (size_t)(64 * (j - 1) + 16 * i) * D); }
        }
        if (w_act) {
            const LAS unsigned char* Kb = Kl + kread;
            f32x16 p0, p1;
#pragma unroll
            for (int r = 0; r < 16; ++r) { p0[r] = 0.f; p1[r] = 0.f; }
#pragma unroll
            for (int d0 = 0; d0 < 4; ++d0) {
                const bf16x8 k0 = *(const LAS bf16x8*)(Kb + d0 * 32), k1 = *(const LAS bf16x8*)(Kb + 16 * AK_STRIDE + d0 * 32);
                p0 = __builtin_amdgcn_mfma_f32_32x32x16_bf16(k0, qf[d0], p0, 0, 0, 0);
                p1 = __builtin_amdgcn_mfma_f32_32x32x16_bf16(k1, qf[d0], p1, 0, 0, 0);
            }
            const int kb0 = 64 * j + 32 * hi;
            const bool partial = (j == jw);
            f32x2 W[16];
#pragma unroll
            for (int r = 0; r < 16; ++r) {
                f32x2 E; E.x = __builtin_amdgcn_exp2f(p0[r]); E.y = __builtin_amdgcn_exp2f(p1[r]);
                const f32x2 Dv = E + 1.0f;
                const float rc = __builtin_amdgcn_rcpf(Dv.x * Dv.y);
                W[r] = (f32x2){Dv.y, Dv.x} * rc;
                if (partial) { if (kb0 + r >= tq) W[r].x = 1.0f; if (kb0 + 16 + r >= tq) W[r].y = 1.0f; }
            }
            f32x2 L = (f32x2){1.0f, 1.0f};
#pragma unroll
            for (int r = 15; r >= 0; --r) { const f32x2 LN = L * W[r]; W[r] = L - LN; L = LN; }
            const float l1 = L.y, l = L.x * L.y;
            float T0, T1;
            { auto rr = __builtin_amdgcn_permlane32_swap(__float_as_uint(l), __float_as_uint(l), false, false); T0 = __uint_as_float(rr[0]); T1 = __uint_as_float(rr[1]); }
            const float pre = hi ? R : R * T1;
            const f32x2 PS = (f32x2){pre * l1, pre};
            R = R * T1 * T0;
#pragma unroll
            for (int r = 0; r < 16; ++r) W[r] = W[r] * PS;
            u32x4 pa[4];
#pragma unroll
            for (int q = 0; q < 4; ++q) { pa[0][q] = cvt_pk_bf16(W[2 * q].x, W[2 * q + 1].x); pa[1][q] = cvt_pk_bf16(W[8 + 2 * q].x, W[9 + 2 * q].x);
                                          pa[2][q] = cvt_pk_bf16(W[2 * q].y, W[2 * q + 1].y); pa[3][q] = cvt_pk_bf16(W[8 + 2 * q].y, W[9 + 2 * q].y); }
            const LAS unsigned char* Vb = Vl + vread;
#pragma unroll
            for (int m = 0; m < 4; ++m) {
                const s16x4 a0 = vtr(Vb + (8 * m) * AV_STRIDE), a1 = vtr(Vb + (8 * m + 4) * AV_STRIDE);
                const s16x4 c0 = vtr(Vb + (8 * m) * AV_STRIDE + 64), c1 = vtr(Vb + (8 * m + 4) * AV_STRIDE + 64);
                const bf16x8 v0 = (bf16x8){a0[0], a0[1], a0[2], a0[3], a1[0], a1[1], a1[2], a1[3]};
                const bf16x8 v1 = (bf16x8){c0[0], c0[1], c0[2], c0[3], c1[0], c1[1], c1[2], c1[3]};
                const bf16x8 pf2 = __builtin_bit_cast(bf16x8, pa[m]);
                o0 = __builtin_amdgcn_mfma_f32_32x32x16_bf16(pf2, v0, o0, 0, 0, 0);
                o1 = __builtin_amdgcn_mfma_f32_32x32x16_bf16(pf2, v1, o1, 0, 0, 0);
            }
            w_act = (j > 0) && !__all(R < ATT_RDONE);
        }
        if (lane == 0) dflag[par * 8 + wid] = w_act ? 0 : 1;
        PAIR_SYNC();
        const int fa = dflag[par * 8 + 2 * pair] & dflag[par * 8 + 2 * pair + 1];
        par ^= 1;
        if (fa != 0) break;
        if (j > 0) {
            if (!pf) {
#pragma unroll
                for (int i = 0; i < 4; ++i) { kreg[i] = *(const GAS u32x4*)(kgp + (size_t)(64 * (j - 1) + 16 * i) * D); vreg[i] = *(const GAS u32x4*)(vgp + (size_t)(64 * (j - 1) + 16 * i) * D); }
            }
#pragma unroll
            for (int i = 0; i < 4; ++i) { *(LAS u32x4*)(kst + 16 * i * AK_STRIDE) = kreg[i]; *(LAS u32x4*)(vst + 16 * i * AV_STRIDE) = vreg[i]; }
        }
        PAIR_SYNC();
    }
    {
        const int j4 = r32 & 3, m4 = r32 >> 2;
        const unsigned selj = (unsigned)j4 | ((unsigned)(4 + j4) << 8) | 0x0c0c0000u;
        unsigned char* Ow = (unsigned char*)O + (rowbase + Tq0 + 32 * wid + j4 + 4 * hi) * D + h * HD + 4 * m4;
#pragma unroll
        for (int half = 0; half < 2; ++half)
#pragma unroll
            for (int k = 0; k < 4; ++k) {
                const unsigned bw = half == 0 ? cvt_pk4_fp8(o0[4 * k], o0[4 * k + 1], o0[4 * k + 2], o0[4 * k + 3]) : cvt_pk4_fp8(o1[4 * k], o1[4 * k + 1], o1[4 * k + 2], o1[4 * k + 3]);
                const unsigned q0 = (unsigned)__builtin_amdgcn_update_dpp(0, (int)bw, 0x00, 0xf, 0xf, false), q1 = (unsigned)__builtin_amdgcn_update_dpp(0, (int)bw, 0x55, 0xf, 0xf, false);
                const unsigned q2 = (unsigned)__builtin_amdgcn_update_dpp(0, (int)bw, 0xaa, 0xf, 0xf, false), q3 = (unsigned)__builtin_amdgcn_update_dpp(0, (int)bw, 0xff, 0xf, 0xf, false);
                const unsigned t01 = __builtin_amdgcn_perm(q1, q0, selj), t23 = __builtin_amdgcn_perm(q3, q2, selj);
                const unsigned dv = __builtin_amdgcn_perm(t23, t01, 0x05040100u);
                *(GAS unsigned*)(Ow + (size_t)(8 * k) * D + 32 * half) = dv;
            }
    }
#undef PAIR_SYNC
}

constexpr int RT_WSTRIDE = 2064;
constexpr int RT_LG_OFF = 32 * RT_WSTRIDE;
constexpr int RT_HIST_OFF = RT_LG_OFF + 8 * 16 * 33 * 4;
__device__ __forceinline__ void router_phase(LAS unsigned char* lds, const bf16_t* h, const bf16_t* wrt  , const float* rb, unsigned* gcnt, int* toks, float* gl, int* slot, int vcu, int G) {
    const int tid = opaque_tid(), lane = tid & 63, wave = __builtin_amdgcn_readfirstlane(tid >> 6);
    for (int i = tid; i < 32 * 128; i += NWAVES * 64) { const int e = i >> 7, ch = i & 127; *(LAS u32x4*)(lds + e * RT_WSTRIDE + ch * 16) = *(const GAS u32x4*)(wrt + (size_t)e * D + ch * 8); }
    LAS int* lcnt = (LAS int*)(lds + RT_HIST_OFF); LAS int* lbase = lcnt + 32;
    LAS float* lg = (LAS float*)(lds + RT_LG_OFF) + wave * 16 * 33;
    __syncthreads();
    const int r16 = lane & 15, kq = lane >> 4;
    for (int chunk = vcu; chunk < NTOK / 256; chunk += G) {
        if (tid < 32) lcnt[tid] = 0;
        __syncthreads();
        int se[2][4], sp[2][4]; float sg[2][4];
#pragma unroll
        for (int g = 0; g < 2; ++g) {
            const int row0 = chunk * 256 + wave * 32 + g * 16;
            f32x4 a0 = (f32x4){0.f, 0.f, 0.f, 0.f}, a1 = a0;
            const bf16_t* hp = h + (size_t)(row0 + r16) * D + 8 * kq;
            const LAS unsigned char* wp = lds + r16 * RT_WSTRIDE + kq * 16;
            bf16x8 av[32];
#pragma unroll
            for (int ks = 0; ks < 32; ++ks) av[ks] = *(const GAS bf16x8*)(hp + 32 * ks);
#pragma unroll
            for (int ks = 0; ks < 32; ++ks) {
                const bf16x8 b0 = *(const LAS bf16x8*)(wp + ks * 64), b1 = *(const LAS bf16x8*)(wp + 16 * RT_WSTRIDE + ks * 64);
                a0 = __builtin_amdgcn_mfma_f32_16x16x32_bf16(av[ks], b0, a0, 0, 0, 0);
                a1 = __builtin_amdgcn_mfma_f32_16x16x32_bf16(av[ks], b1, a1, 0, 0, 0);
            }
#pragma unroll
            for (int i = 0; i < 4; ++i) { lg[(4 * kq + i) * 33 + r16] = a0[i]; lg[(4 * kq + i) * 33 + 16 + r16] = a1[i]; }
            LDS_WAIT(); asm volatile("" ::: "memory");
            if (lane < 16) {
                float v[32];
#pragma unroll
                for (int e = 0; e < 32; ++e) v[e] = lg[lane * 33 + e] + rb[e];
                unsigned used = 0u; float tv[4];
#pragma unroll
                for (int k = 0; k < 4; ++k) {
                    float best = -INFINITY; int bi = 0;
#pragma unroll
                    for (int e = 0; e < 32; ++e) { const bool ok = !((used >> e) & 1u) && (v[e] > best); best = ok ? v[e] : best; bi = ok ? e : bi; }
                    used |= 1u << bi; se[g][k] = bi; tv[k] = best;
                }
                const float e1 = __expf(tv[1] - tv[0]), e2 = __expf(tv[2] - tv[0]), e3 = __expf(tv[3] - tv[0]);
                const float inv = 1.0f / (1.0f + e1 + e2 + e3);
                sg[g][0] = inv; sg[g][1] = e1 * inv; sg[g][2] = e2 * inv; sg[g][3] = e3 * inv;
#pragma unroll
                for (int k = 0; k < 4; ++k) sp[g][k] = __hip_atomic_fetch_add(&lcnt[se[g][k]], 1, __ATOMIC_RELAXED, __HIP_MEMORY_SCOPE_WORKGROUP);
            }
            LDS_WAIT(); asm volatile("" ::: "memory");
        }
        __syncthreads();
        if (tid < 32) lbase[tid] = (int)__hip_atomic_fetch_add(gcnt + tid, (unsigned)lcnt[tid], RLX_AGENT);
        __syncthreads();
        if (lane < 16) {
#pragma unroll
            for (int g = 0; g < 2; ++g) {
                const int tok = chunk * 256 + wave * 32 + g * 16 + lane;
#pragma unroll
                for (int k = 0; k < 4; ++k) { const int e = se[g][k], pos = lbase[e] + sp[g][k];
                    ((GAS int*)toks)[(size_t)e * CAP + pos] = tok; ((GAS float*)gl)[(size_t)e * CAP + pos] = sg[g][k]; ((GAS int*)slot)[tok * 4 + k] = (e << 16) | pos; }
            }
        }
        __syncthreads();
    }
}
constexpr int NR_TSTRIDE = 528;
constexpr int NR_TILE_OFF = 32 * RT_WSTRIDE;
constexpr int NR_LG_OFF = NR_TILE_OFF + 8 * 16 * NR_TSTRIDE;
constexpr int NR_HIST_OFF = NR_LG_OFF + 8 * 16 * 33 * 4;
static_assert(NR_HIST_OFF + 256 <= LDSCTL_OFF, "norm+router scratch fits under the control words");
__device__ __forceinline__ void normrouter_phase(LAS unsigned char* lds, const bf16_t* __restrict__ x, const float* g, const float* modl, unsigned char* __restrict__ h8, const bf16_t* wrt, const float* rb,
                                                 unsigned* gcnt, int* toks, float* gl, int* slot, int vcu, int G) {
    const int tid = opaque_tid(), lane = tid & 63, wave = __builtin_amdgcn_readfirstlane(tid >> 6);
    for (int i = tid; i < 32 * 128; i += NWAVES * 64) { const int e = i >> 7, ch = i & 127; *(LAS u32x4*)(lds + e * RT_WSTRIDE + ch * 16) = *(const GAS u32x4*)(wrt + (size_t)e * D + ch * 8); }
    LAS int* lcnt = (LAS int*)(lds + NR_HIST_OFF); LAS int* lbase = lcnt + 32;
    LAS float* lg = (LAS float*)(lds + NR_LG_OFF) + wave * 16 * 33;
    LAS unsigned char* tile = lds + NR_TILE_OFF + wave * 16 * NR_TSTRIDE;
    __syncthreads();
    const int r16 = lane & 15, kq = lane >> 4;
    for (int chunk = vcu; chunk < NTOK / 256; chunk += G) {
        if (tid < 32) lcnt[tid] = 0;
        __syncthreads();
        const int row0 = chunk * 256 + wave * 32, b = row0 / SEQ;
        int se[2][4], sp[2][4]; float sg[2][4];
#pragma unroll
        for (int gI = 0; gI < 2; ++gI) {
            const int r0 = row0 + gI * 16;
            u32x2 raw[16][4];
#pragma unroll
            for (int q = 0; q < 16; ++q) { const GAS u32x2* xr = (const GAS u32x2*)(x + (size_t)(r0 + q) * D) + lane;
#pragma unroll
                for (int j = 0; j < 4; ++j) raw[q][j] = xr[64 * j]; }
            float rinv[16];
#pragma unroll
            for (int q = 0; q < 16; ++q) {
                float ssum = 0.f;
#pragma unroll
                for (int j = 0; j < 4; ++j) { const float x0 = bf_lo(raw[q][j].x), x1 = bf_hi(raw[q][j].x), x2 = bf_lo(raw[q][j].y), x3 = bf_hi(raw[q][j].y); ssum += (x0 * x0 + x1 * x1) + (x2 * x2 + x3 * x3); }
                rinv[q] = rsqrtf(wave_sum(ssum) * (1.0f / D) + EPS);
            }
            f32x4 a0 = (f32x4){0.f, 0.f, 0.f, 0.f}, a1 = a0;
            const LAS unsigned char* ap = tile + r16 * NR_TSTRIDE + kq * 16;
#pragma unroll
            for (int j = 0; j < 4; ++j) {
                const int cidx = 4 * lane + 256 * j;
                const f32x4 avj = *(const GAS f32x4*)(g + cidx) * (*(const GAS f32x4*)(modl + (size_t)b * 6144 + 4096 + cidx) + 1.0f), svj = *(const GAS f32x4*)(modl + (size_t)b * 6144 + 3072 + cidx);
#pragma unroll
                for (int q = 0; q < 16; ++q) {
                    unsigned rwx = raw[q][j].x, rwy = raw[q][j].y; asm volatile("" : "+v"(rwx), "+v"(rwy));
                    const f32x4 xv = (f32x4){bf_lo(rwx), bf_hi(rwx), bf_lo(rwy), bf_hi(rwy)};
                    const f32x4 y = xv * rinv[q] * avj + svj;
                    u32x2 w2; w2.x = cvt_pk_bf16(y.x, y.y); w2.y = cvt_pk_bf16(y.z, y.w);
                    *((LAS u32x2*)(tile + q * NR_TSTRIDE) + lane) = w2;
                    *((GAS unsigned*)(h8 + (size_t)(r0 + q) * D + 256 * j) + lane) = cvt_pk4_fp8(y.x, y.y, y.z, y.w);
                }
                LDS_WAIT(); asm volatile("" ::: "memory");
                const LAS unsigned char* wp = lds + r16 * RT_WSTRIDE + kq * 16 + j * 512;
#pragma unroll
                for (int ks = 0; ks < 8; ++ks) {
                    const bf16x8 afr = *(const LAS bf16x8*)(ap + ks * 64);
                    const bf16x8 b0 = *(const LAS bf16x8*)(wp + ks * 64), b1 = *(const LAS bf16x8*)(wp + 16 * RT_WSTRIDE + ks * 64);
                    a0 = __builtin_amdgcn_mfma_f32_16x16x32_bf16(afr, b0, a0, 0, 0, 0);
                    a1 = __builtin_amdgcn_mfma_f32_16x16x32_bf16(afr, b1, a1, 0, 0, 0);
                }
                LDS_WAIT(); asm volatile("" ::: "memory");
            }
            { const float rb0 = ((const GAS float*)rb)[r16], rb1 = ((const GAS float*)rb)[16 + r16];
#pragma unroll
              for (int i = 0; i < 4; ++i) { lg[(4 * kq + i) * 33 + r16] = a0[i] + rb0; lg[(4 * kq + i) * 33 + 16 + r16] = a1[i] + rb1; } }
            LDS_WAIT(); asm volatile("" ::: "memory");
            float tv[4];
            {
                const int prt = lane >> 4;
                float v[8];
#pragma unroll
                for (int i = 0; i < 8; ++i) v[i] = lg[(lane & 15) * 33 + 8 * prt + i];
                unsigned used = 0u;
#pragma unroll
                for (int k = 0; k < 4; ++k) {
                    float best = -INFINITY; int bi = 8 * prt;
#pragma unroll
                    for (int i = 0; i < 8; ++i) { const bool ok = !((used >> i) & 1u) && (v[i] > best); best = ok ? v[i] : best; bi = ok ? 8 * prt + i : bi; }
#pragma unroll
                    for (int st = 16; st <= 32; st <<= 1) { const float ob = __shfl_xor(best, st); const int oi = __shfl_xor(bi, st); const bool take = (ob > best) || (ob == best && oi < bi); best = take ? ob : best; bi = take ? oi : bi; }
                    if ((bi >> 3) == prt) used |= 1u << (bi & 7);
                    se[gI][k] = bi; tv[k] = best;
                }
            }
            if (lane < 16) {
                const float e1 = __expf(tv[1] - tv[0]), e2 = __expf(tv[2] - tv[0]), e3 = __expf(tv[3] - tv[0]);
                const float inv = 1.0f / (1.0f + e1 + e2 + e3);
                sg[gI][0] = inv; sg[gI][1] = e1 * inv; sg[gI][2] = e2 * inv; sg[gI][3] = e3 * inv;
#pragma unroll
                for (int k = 0; k < 4; ++k) sp[gI][k] = __hip_atomic_fetch_add(&lcnt[se[gI][k]], 1, __ATOMIC_RELAXED, __HIP_MEMORY_SCOPE_WORKGROUP);
            }
            LDS_WAIT(); asm volatile("" ::: "memory");
        }
        __syncthreads();
        { const int t2 = opaque_tid();
          if (t2 < 32) lbase[t2] = (int)__hip_atomic_fetch_add((unsigned*)opaque_ptr((unsigned char*)gcnt) + t2, (unsigned)lcnt[t2], RLX_AGENT); }
        __syncthreads();
        if (lane < 16) {
#pragma unroll
            for (int gI = 0; gI < 2; ++gI) {
                const int tok = row0 + gI * 16 + lane;
#pragma unroll
                for (int k = 0; k < 4; ++k) { const int e = se[gI][k], pos = lbase[e] + sp[gI][k];
                    ((GAS int*)toks)[(size_t)e * CAP + pos] = tok; ((GAS float*)gl)[(size_t)e * CAP + pos] = sg[gI][k]; ((GAS int*)slot)[tok * 4 + k] = (e << 16) | pos; }
            }
        }
        __syncthreads();
    }
}
__device__ __forceinline__ void moe_tables(LAS int* tab, unsigned* gcnt) {
    const int tid = opaque_tid();
    __syncthreads();
    if (tid < 32) tab[40 + tid] = (int)__hip_atomic_load(gcnt + tid, RLX_AGENT);
    __syncthreads();
    if (tid == 0) { int s = 0; for (int e = 0; e < 32; ++e) { tab[e] = s; s += (tab[40 + e] + 255) >> 8; } tab[32] = s; }
    __syncthreads();
    { LAS int* tinfo = tab + (TINFO_OFF - TAB_OFF) / 4; const int Tm = tab[32];
      for (int mt = tid; mt < Tm; mt += NWAVES * 64) { int e = 0;
#pragma unroll
          for (int s = 16; s >= 1; s >>= 1) { if (tab[e + s] <= mt) e += s; }
          tinfo[mt] = (e << 16) | (mt - tab[e]); } }
    __syncthreads();
}
__device__ __forceinline__ void combine_phase(bf16_t* x, float* xfinal, const unsigned char* __restrict__ Y, const int* __restrict__ slot, const float* __restrict__ gl, const LAS int* tab, const float* modl, bool donorm, const float* gn, const float* modn, bf16_t* __restrict__ h, unsigned char* __restrict__ h8, int vcu, int G) {
    const int tid = opaque_tid(), lane = tid & 63, gw = vcu * NWAVES + __builtin_amdgcn_readfirstlane(tid >> 6), NGW = G * NWAVES;
    for (int w = gw; w < NTOK / 32; w += NGW) {
        const int row0 = w * 32, b = row0 / SEQ;
        f32x4 gtv[4], av[4], sv[4];
#pragma unroll
        for (int j = 0; j < 4; ++j) { const int cidx = 4 * lane + 256 * j; gtv[j] = *(const GAS f32x4*)(modl + (size_t)b * 6144 + 5120 + cidx);
            if (donorm) { av[j] = *(const GAS f32x4*)(gn + cidx) * (*(const GAS f32x4*)(modn + (size_t)b * 6144 + 1024 + cidx) + 1.0f); sv[j] = *(const GAS f32x4*)(modn + (size_t)b * 6144 + cidx); }
            else { av[j] = (f32x4){0.f, 0.f, 0.f, 0.f}; sv[j] = av[j]; } }
        i32x4 sl[2];
#pragma unroll
        for (int q = 0; q < 2; ++q) sl[q] = *(const GAS i32x4*)(slot + (row0 + q) * 4);
#pragma nounroll
        for (int r = 0; r < 32; r += 2) {
            unsigned yv[2][4][4]; f32x4 xv[2][4]; float gk[2][4];
            i32x4 sn[2];
            { const int rn = (r + 2 < 32) ? r + 2 : r;
#pragma unroll
              for (int q = 0; q < 2; ++q) sn[q] = *(const GAS i32x4*)(slot + (row0 + rn + q) * 4); }
#pragma unroll
            for (int q = 0; q < 2; ++q) {
                const int tok = row0 + r + q;
                const i32x4 s4 = sl[q];
#pragma unroll
                for (int k = 0; k < 4; ++k) { const int sk = s4[k]; const int e = sk >> 16, pos = sk & 0xffff; const int yrow = tab[e] * 256 + pos;
                    gk[q][k] = ((const GAS float*)gl)[(size_t)e * CAP + pos];
                    const GAS unsigned* yp = (const GAS unsigned*)(Y + (size_t)yrow * D) + lane;
#pragma unroll
                    for (int j = 0; j < 4; ++j) yv[q][k][j] = __builtin_nontemporal_load(yp + 64 * j); }
                const GAS u32x2* xr = (const GAS u32x2*)(x + (size_t)tok * D) + lane;
#pragma unroll
                for (int j = 0; j < 4; ++j) { const u32x2 w = xr[64 * j]; xv[q][j] = (f32x4){bf_lo(w.x), bf_hi(w.x), bf_lo(w.y), bf_hi(w.y)}; }
            }
#pragma unroll
            for (int q = 0; q < 2; ++q) {
                const int tok = row0 + r + q;
                GAS u32x2* xw = (GAS u32x2*)(x + (size_t)tok * D) + lane; GAS f32x4* xf = (GAS f32x4*)(xfinal + (size_t)tok * D) + lane;
                f32x4 v[4]; float ss = 0.f;
#pragma unroll
                for (int j = 0; j < 4; ++j) {
                    f32x4 s4 = (f32x4){0.f, 0.f, 0.f, 0.f};
#pragma unroll
                    for (int k = 0; k < 4; ++k) { const unsigned yy = yv[q][k][j]; const f32x2 lo = __builtin_amdgcn_cvt_pk_f32_fp8((int)yy, false), hi2 = __builtin_amdgcn_cvt_pk_f32_fp8((int)yy, true); const float gg = gk[q][k]; s4.x += gg * lo[0]; s4.y += gg * lo[1]; s4.z += gg * hi2[0]; s4.w += gg * hi2[1]; }
                    v[j] = xv[q][j] + gtv[j] * s4;
                    if (xfinal) __builtin_nontemporal_store(v[j], xf + 64 * j); else { u32x2 w2; w2.x = cvt_pk_bf16(v[j].x, v[j].y); w2.y = cvt_pk_bf16(v[j].z, v[j].w); xw[64 * j] = w2; }
                    ss += (v[j].x * v[j].x + v[j].y * v[j].y) + (v[j].z * v[j].z + v[j].w * v[j].w);
                }
                if (donorm) {
                    const float rinv = rsqrtf(wave_sum(ss) * (1.0f / D) + EPS);
                    GAS u32x2* o8 = (GAS u32x2*)(h + (size_t)tok * D) + lane; GAS unsigned* o4 = (GAS unsigned*)(h8 + (size_t)tok * D) + lane;
#pragma unroll
                    for (int j = 0; j < 4; ++j) { const f32x4 y = v[j] * rinv * av[j] + sv[j];
                        if (h8) o4[64 * j] = cvt_pk4_fp8(y.x, y.y, y.z, y.w);
                        else { u32x2 w2; w2.x = cvt_pk_bf16(y.x, y.y); w2.y = cvt_pk_bf16(y.z, y.w); o8[64 * j] = w2; } }
                }
            }
            sl[0] = sn[0]; sl[1] = sn[1];
        }
    }
}

__global__ void __launch_bounds__(NWAVES * 64, 2) fwd_kernel(Args args) {
    extern __shared__ __attribute__((aligned(16))) unsigned char lds_raw[];
    LAS unsigned char* lds = (LAS unsigned char*)lds_raw;
    const int G = gridDim.x; const int bx = blockIdx.x; const int vcu = (G % 8 == 0) ? (bx % 8) * (G / 8) + bx / 8 : bx;
    gu32* ctl = (gu32*)(args.ws + WS_CTL);
    for (int u = threadIdx.x; u < (LDS_BYTES - LDSCTL_OFF) / 4; u += NWAVES * 64) ((LAS unsigned*)(lds + LDSCTL_OFF))[u] = 0u;
    __syncthreads();
    (void)xcd_barrier_post((unsigned*)(ctl + CW_BAR), (volatile LAS unsigned*)(lds + MISC_OFF));
#define GRID_BAR() do { XcdBarrier _b; _b.bar = (unsigned*)((gu32*)(opaque_ptr(args.ws) + WS_CTL) + CW_BAR); _b.x = xb_xcc_id(); _b.st = (volatile LAS unsigned*)(lds + MISC_OFF); xcd_barrier(_b); } while (0)
    LAS int* tab = (LAS int*)(lds + TAB_OFF);

#define LOCAL_SYNC() do { asm volatile("s_waitcnt vmcnt(0)" ::: "memory"); __syncthreads(); } while (0)
#define WSP(off) (opaque_ptr(args.ws) + (off))
    prologue(args, lds, vcu, G);
    GRID_BAR();
    norm_phase(args.x, args.norm1_g, (const float*)WSP(WS_MOD), 0, 1024, (bf16_t*)WSP(WS_H), nullptr, vcu, G);
    GRID_BAR();

#pragma nounroll
    for (int l = 0; l < DEPTH; ++l) {
        const int j = l >> 1;
        if ((l & 1) == 0) {
            { pg8::StaticOrder S; S.init(NTOK, 3072, opaque_sint(G), opaque_sint(bx)); pg8::EpiConvIn E{(bf16_t*)WSP(WS_A1), (bf16_t*)WSP(WS_A2)};
              pg8::gemm_phase<pg8::EpiConvIn, pg8::StaticOrder, true, 2>(lds, WSP(WS_H), WSP(WS_WCIN) + (size_t)j * 3072 * D * 2, D, S, E); }
            GRID_BAR();
            conv_phase((const bf16_t*)WSP(WS_A1), (const bf16_t*)WSP(WS_A2), args.conv_w + (size_t)j * 3 * D, WSP(WS_A3), vcu, G);
            LOCAL_SYNC();
            { pg8::PanelOrderG S; S.init(NTOK, D, opaque_sint(G), opaque_sint(vcu)); if (l == 0) { pg8::EpiResidT<true> E{args.x, (bf16_t*)WSP(WS_XB), (const float*)WSP(WS_MOD) + (size_t)l * NB * 6144 + 2048};
                pg8::gemm_phase<pg8::EpiResidT<true>, pg8::PanelOrderG, true, 1>(lds, WSP(WS_A3), WSP(WS_WCOUT) + (size_t)j * D * D, D, S, E); }
              else { pg8::EpiResidT<false> E{WSP(WS_XB), (bf16_t*)WSP(WS_XB), (const float*)WSP(WS_MOD) + (size_t)l * NB * 6144 + 2048};
                pg8::gemm_phase<pg8::EpiResidT<false>, pg8::PanelOrderG, true, 1>(lds, WSP(WS_A3), WSP(WS_WCOUT) + (size_t)j * D * D, D, S, E); } }
            LOCAL_SYNC();
        } else {
            { LAS float* qkg = (LAS float*)(lds + RING_BYTES); const int t_ = opaque_tid();
              if (t_ < 128) qkg[t_] = t_ < 64 ? ((const GAS float*)args.attn_q_g)[j * HD + t_] * C2 : ((const GAS float*)args.attn_k_g)[j * HD + t_ - 64];
              __syncthreads(); }
            { pg8::StaticOrderG S; S.init(NTOK, 3072, opaque_sint(G), opaque_sint(bx)); pg8::EpiQKV E{(bf16_t*)WSP(WS_A1), (bf16_t*)WSP(WS_A2), (bf16_t*)WSP(WS_A3), (const LAS float*)(lds + RING_BYTES)};
              pg8::gemm_phase<pg8::EpiQKV, pg8::StaticOrderG, true, 1>(lds, WSP(WS_H8), WSP(WS_WQKV) + (size_t)j * 3072 * D, D, S, E); }
            GRID_BAR();
            int apar = 0, apsn = 0;
            { const int t_ = opaque_tid(); if (t_ < 4) ((LAS int*)(lds + AP_FLAG + 256))[t_ * 16] = 0; __syncthreads(); }
            for (int pn = vcu; pn < NB * (SEQ / 256); pn += G)
                for (int hh = 0; hh < NH; ++hh) attn_unit_pairs(lds, (const bf16_t*)WSP(WS_A1), (const bf16_t*)WSP(WS_A2), (const bf16_t*)WSP(WS_A3), (bf16_t*)WSP(WS_H), pn / (SEQ / 256), hh, pn % (SEQ / 256), apar, apsn);
            LOCAL_SYNC();
            { pg8::PanelOrderG S; S.init(NTOK, D, opaque_sint(G), opaque_sint(vcu)); pg8::EpiResidT<false> E{WSP(WS_XB), (bf16_t*)WSP(WS_XB), (const float*)WSP(WS_MOD) + (size_t)l * NB * 6144 + 2048};
              pg8::gemm_phase<pg8::EpiResidT<false>, pg8::PanelOrderG, true, 1>(lds, WSP(WS_H), WSP(WS_WO) + (size_t)j * D * D, D, S, E); }
            LOCAL_SYNC();
        }
        normrouter_phase(lds, (const bf16_t*)WSP(WS_XB), args.norm2_g + (size_t)l * D, (const float*)WSP(WS_MOD) + (size_t)l * NB * 6144, WSP(WS_H8), (const bf16_t*)WSP(WS_WR) + (size_t)l * NE * D, args.router_b + l * NE,
                         (unsigned*)((gu32*)WSP(WS_CTL) + CW_CNT + l * 32), (int*)WSP(WS_TOK), (float*)WSP(WS_GL), (int*)WSP(WS_SLOT), vcu, G);
        GRID_BAR();
        moe_tables(tab, (unsigned*)((gu32*)WSP(WS_CTL) + CW_CNT + l * 32));
        { pg8::MoeOrderT<true> S; S.init(tab, (const int*)WSP(WS_TOK), 8, opaque_sint(G), opaque_sint(bx)); pg8::EpiMoe1 E{WSP(WS_ACT), args.moe_b1 + (size_t)l * NE * 2048};
          pg8::gemm_phase<pg8::EpiMoe1, pg8::MoeOrderT<true>, true, 1>(lds, WSP(WS_H8), WSP(WS_W1) + (size_t)l * NE * 2048 * D, D, S, E); }
        GRID_BAR();
        { pg8::MoeOrderI S; S.init(tab, (const int*)WSP(WS_TOK), 4, opaque_sint(G), opaque_sint(bx)); pg8::EpiMoe2 E{WSP(WS_Y), args.moe_b2 + (size_t)l * NE * D, (const float*)WSP(WS_GL), tab};
          pg8::gemm_phase<pg8::EpiMoe2, pg8::MoeOrderI, true, 1>(lds, WSP(WS_ACT), WSP(WS_W2) + (size_t)l * NE * D * FF, FF, S, E); }
        GRID_BAR();
        { const bool dn = (l + 1 < DEPTH);
          combine_phase((bf16_t*)WSP(WS_XB), dn ? (float*)nullptr : args.out, WSP(WS_Y), (const int*)WSP(WS_SLOT), (const float*)WSP(WS_GL), tab, (const float*)WSP(WS_MOD) + (size_t)l * NB * 6144, dn, args.norm1_g + (size_t)(dn ? l + 1 : l) * D, (const float*)WSP(WS_MOD) + (size_t)(dn ? l + 1 : l) * NB * 6144, (bf16_t*)WSP(WS_H), ((l & 1) == 0) ? WSP(WS_H8) : (unsigned char*)nullptr, vcu, G); }
        if (l + 1 < DEPTH) GRID_BAR();
    }
}

extern "C" void kernel_launch(void* const* d_in, const int* in_sizes, int n_in, void* d_out, int out_size, void* d_ws, size_t ws_size, hipStream_t stream) {
    static int grid = 0;
    if (grid == 0) {
        if (n_in != 19 || out_size != NTOK * D || ws_size < WS_END) { fprintf(stderr, "kernel_launch: unexpected shapes (n_in %d out %d ws %zu)\n", n_in, out_size, ws_size); grid = -1; return; }
        int dev = 0, cus = 0, per_cu = 0;
        if (hipGetDevice(&dev) != hipSuccess || hipDeviceGetAttribute(&cus, hipDeviceAttributeMultiprocessorCount, dev) != hipSuccess) { grid = -1; return; }
        if (hipFuncSetAttribute((const void*)fwd_kernel, hipFuncAttributeMaxDynamicSharedMemorySize, LDS_BYTES) != hipSuccess) { fprintf(stderr, "kernel_launch: hipFuncSetAttribute failed\n"); grid = -1; return; }
        if (hipOccupancyMaxActiveBlocksPerMultiprocessor(&per_cu, (const void*)fwd_kernel, NWAVES * 64, LDS_BYTES) != hipSuccess || per_cu < 1) { fprintf(stderr, "kernel_launch: occupancy query says %d\n", per_cu); }
        (void)hipGetLastError();
        grid = cus;
    }
    if (grid < 0) return;
    if (hipMemsetAsync((char*)d_ws + WS_CTL, 0, CTL_ZERO_BYTES, stream) != hipSuccess) return;
    Args a{};
    const float* const* in = (const float* const*)d_in;
    a.x = in[0]; a.c = in[1]; a.norm1_g = in[2]; a.norm2_g = in[3]; a.ada_w = in[4]; a.ada_b = in[5]; a.conv_w_in = in[6]; a.conv_w = in[7]; a.conv_w_out = in[8];
    a.attn_w_qkv = in[9]; a.attn_q_g = in[10]; a.attn_k_g = in[11]; a.attn_w_o = in[12]; a.router_w = in[13]; a.router_b = in[14]; a.moe_w1 = in[15]; a.moe_b1 = in[16];
    a.moe_w2 = in[17]; a.moe_b2 = in[18]; a.out = (float*)d_out; a.ws = (unsigned char*)d_ws;
    hipLaunchKernelGGL(fwd_kernel, dim3(grid), dim3(NWAVES * 64), LDS_BYTES, stream, a);
}
```

```cpp
#include <hip/hip_runtime.h>
#include <cstdio>
#include <cstdint>

#define LAS __attribute__((address_space(3)))
#define GAS __attribute__((address_space(1)))
typedef unsigned short bf16_t;
typedef short bf16x8 __attribute__((ext_vector_type(8)));
typedef short s16x4 __attribute__((ext_vector_type(4)));
typedef float f32x4 __attribute__((ext_vector_type(4)));
typedef float f32x2 __attribute__((ext_vector_type(2)));
typedef float f32x16 __attribute__((ext_vector_type(16)));
typedef unsigned u32x4 __attribute__((ext_vector_type(4)));
typedef unsigned u32x2 __attribute__((ext_vector_type(2)));
typedef GAS unsigned gu32;
typedef int i32x4 __attribute__((ext_vector_type(4)));
typedef int i32x8 __attribute__((ext_vector_type(8)));

constexpr int D = 1024, NB = 16, SEQ = 4096, NTOK = NB * SEQ, DEPTH = 4, NH = 16, HD = 64, NE = 32, TOPK = 4, FF = 1024;
constexpr int CAP = NTOK;
constexpr int NROWS_PAD = NTOK * TOPK + NE * 256;
constexpr float EPS = 1e-6f;
constexpr float C2 = 0.125f * 1.4426950408889634f;

constexpr size_t MiB = 1u << 20;
constexpr size_t WS_CTL = 0, CTL_ZERO_BYTES = 1 * MiB;
constexpr size_t WS_MOD = 1 * MiB;
constexpr size_t WS_WR = 3 * MiB;
constexpr size_t WS_WCIN = 4 * MiB;
constexpr size_t WS_WCOUT = 16 * MiB;
constexpr size_t WS_WQKV = 20 * MiB;
constexpr size_t WS_WO = 32 * MiB;
constexpr size_t WS_W1 = 64 * MiB;
constexpr size_t WS_W2 = 576 * MiB;
constexpr size_t WS_H = 832 * MiB;
constexpr size_t WS_A1 = 960 * MiB;
constexpr size_t WS_A2 = 1088 * MiB;
constexpr size_t WS_A3 = 1216 * MiB;
constexpr size_t WS_ACT = 1344 * MiB;
constexpr size_t WS_H8 = 704 * MiB;
constexpr size_t WS_Y = 1872 * MiB;
constexpr size_t WS_TOK = 2400 * MiB;
constexpr size_t WS_GL = 2408 * MiB;
constexpr size_t WS_SLOT = 2416 * MiB;
constexpr size_t WS_XB = 2418 * MiB;
constexpr size_t WS_END = 2546 * MiB;
static_assert(WS_ACT + (size_t)NROWS_PAD * 2048 <= WS_Y && WS_Y + (size_t)NROWS_PAD * 2048 <= WS_TOK, "ws map");
constexpr int CW_BAR = 4096;
constexpr int CW_CNT = 16384;
constexpr int CW_GRPMASK = 20480;
constexpr int CW_GB = 20544;

constexpr int RING_BYTES = 131072;
constexpr int LDSCTL_OFF = 151552;
constexpr int MISC_OFF = LDSCTL_OFF + 64;
constexpr int TAB_OFF = LDSCTL_OFF + 256;
constexpr int TOKTAB_OFF = LDSCTL_OFF + 1024;
constexpr int TINFO_OFF = LDSCTL_OFF + 4096;
constexpr int LDS_BYTES = TINFO_OFF + 1056 * 4;

#define RLX_AGENT __ATOMIC_RELAXED, __HIP_MEMORY_SCOPE_AGENT
#define LDS_WAIT() asm volatile("s_waitcnt lgkmcnt(0)" ::: "memory")
#define VM_WAIT() asm volatile("s_waitcnt vmcnt(0)" ::: "memory")

__device__ __forceinline__ unsigned cvt_pk_bf16(float lo, float hi) { unsigned r; asm volatile("v_cvt_pk_bf16_f32 %0, %1, %2" : "=v"(r) : "v"(lo), "v"(hi)); return r; }
__device__ __forceinline__ unsigned cvt_pk4_fp8(float a, float b, float c, float d) { int r = __builtin_amdgcn_cvt_pk_fp8_f32(a, b, 0, false); r = __builtin_amdgcn_cvt_pk_fp8_f32(c, d, r, true); return (unsigned)r; }
__device__ __forceinline__ float bf_lo(unsigned w) { return __uint_as_float(w << 16); }
__device__ __forceinline__ float bf_hi(unsigned w) { return __uint_as_float(w & 0xffff0000u); }
__device__ __forceinline__ unsigned char* opaque_ptr(unsigned char* p) { asm volatile("" : "+s"(p)); return (unsigned char*)(GAS unsigned char*)p; }
__device__ __forceinline__ int opaque_sint(int v) { asm volatile("" : "+s"(v)); return v; }
__device__ __forceinline__ int opaque_tid() { int t = threadIdx.x; asm volatile("" : "+v"(t)); return t; }
__device__ __forceinline__ float wave_sum(float v) {
#pragma unroll
    for (int o = 1; o < 64; o <<= 1) v += __shfl_xor(v, o);
    return v;
}

#define XB_TMO      128
#define XB_XCNT(j)  (256  + 64 * (j))
#define XB_XSUB(j)  (1280 + 64 * (j))
#define XB_XGEN(j)  (2304 + 64 * (j))
#define XB_TOP      3328
#define XB_TOPGEN   3392
#define XCD_BAR_WORDS 3456
#define XB_SPIN_CAP (1u << 22)

__device__ __forceinline__ unsigned xb_ld(unsigned* p)              { return __hip_atomic_load(p, __ATOMIC_RELAXED, __HIP_MEMORY_SCOPE_AGENT); }
__device__ __forceinline__ unsigned xb_add(unsigned* p, unsigned v) { return __hip_atomic_fetch_add(p, v, __ATOMIC_RELAXED, __HIP_MEMORY_SCOPE_AGENT); }
__device__ __forceinline__ unsigned xb_xcc_id() { return (unsigned)__builtin_amdgcn_s_getreg((3 << 11) | 20) & 0xFu; }
#define XB_SPIN(cond, bar) do { unsigned _sp = 0; while (cond) { __builtin_amdgcn_s_sleep(1); \
    if ((++_sp & 255u) == 0u) { if (xb_ld(&(bar)[XB_TMO])) break; if (_sp > XB_SPIN_CAP) { atomicAdd(&(bar)[XB_TMO], 1u); break; } } } } while (0)

struct XcdBarrier { unsigned* bar; unsigned x; volatile LAS unsigned* st; };

__device__ __forceinline__ XcdBarrier xcd_barrier_post(unsigned* bar, volatile LAS unsigned* st) {
    XcdBarrier b; b.bar = bar; b.x = xb_xcc_id(); b.st = st;
    if (threadIdx.x == 0) (void)xb_add(&bar[XB_XCNT(b.x)], 1u);
    return b;
}
__device__ __forceinline__ void xcd_barrier_complete(unsigned* bar, unsigned x, unsigned& nloc, unsigned& nx) {
    const unsigned G = gridDim.x * gridDim.y * gridDim.z;
    unsigned sum, cnt, mine, sp = 0u;
    for (;;) {
        sum = 0u; cnt = 0u; mine = 0u;
#pragma unroll
        for (unsigned j = 0; j < 16; ++j) { const unsigned c = xb_ld(&bar[XB_XCNT(j)]); sum += c; cnt += (c > 0u) ? 1u : 0u; mine = (j == x) ? c : mine; }
        if (sum == G) break;
        __builtin_amdgcn_s_sleep(1);
        if ((++sp & 255u) == 0u) { if (xb_ld(&bar[XB_TMO])) break; if (sp > XB_SPIN_CAP) { atomicAdd(&bar[XB_TMO], 1u); break; } }
    }
    nloc = mine > 0u ? mine : 1u; nx = cnt > 0u ? cnt : 1u;
}
__device__ __forceinline__ void xcd_barrier(const XcdBarrier& b) {
    asm volatile("s_waitcnt vmcnt(0)" ::: "memory");
    __syncthreads();
    if (threadIdx.x == 0) {
        unsigned* bar = b.bar;
        __builtin_amdgcn_s_waitcnt(0);
        unsigned nloc = b.st[0], nx = b.st[1];
        if (nloc == 0u) { xcd_barrier_complete(bar, b.x, nloc, nx); b.st[0] = nloc; b.st[1] = nx; }
        const unsigned old = xb_add(&bar[XB_XSUB(b.x)], 1u);
        const unsigned gen = old / nloc;
        if (old + 1u == (gen + 1u) * nloc) {
            __builtin_amdgcn_fence(__ATOMIC_RELEASE, "agent");
            asm volatile("s_waitcnt vmcnt(0)" ::: "memory");
            const unsigned og = xb_add(&bar[XB_TOP], 1u);
            const unsigned tg = og / nx;
            if (og + 1u == (tg + 1u) * nx) xb_add(&bar[XB_TOPGEN], 1u);
            else XB_SPIN(xb_ld(&bar[XB_TOPGEN]) == tg, bar);
            __builtin_amdgcn_fence(__ATOMIC_ACQUIRE, "agent");
            xb_add(&bar[XB_XGEN(b.x)], 1u);
            asm volatile("s_waitcnt vmcnt(0)" ::: "memory");
        } else {
            XB_SPIN(xb_ld(&bar[XB_XGEN(b.x)]) == gen, bar);
            __builtin_amdgcn_fence(__ATOMIC_ACQUIRE, "agent");
            asm volatile("s_waitcnt vmcnt(0)" ::: "memory");
        }
    }
    __syncthreads();
}

namespace pg8 {
constexpr int BM = 256, BK = 64, HALF = 128, HTB = HALF * BK * 2, STAGE_BYTES = 8 * HTB, NXCD = 8, WGM = 8;
__device__ __forceinline__ int lds_byte(int r, int c) { const int st = (r >> 4) * 2 + (c >> 5), rr = r & 15, cc = c & 31, ob = rr * 64 + cc * 2; return st * 1024 + (ob ^ (((ob >> 9) & 1) << 5)); }
__device__ __forceinline__ void stage_rc(int b, int& R, int& C) { const int st = b / 1024, sb = b % 1024, swz = sb ^ (((sb >> 9) & 1) << 5); R = (st >> 1) * 16 + swz / 64; C = (st & 1) * 32 + (swz % 64) / 2; }
__device__ __forceinline__ int perm32(int rho) { const int n = rho >> 4, i = rho & 15; return 8 * (i >> 2) + 4 * n + (i & 3); }

struct Unit { int pm, pn, e, mrel, pnl; };

struct StaticOrder {
    static constexpr bool GATHER = false;
    int nM, nN, G, c;
    __device__ void init(int M, int N, int G_, int c_) { nM = M / BM; nN = N / BM; G = G_; c = c_; }
    static constexpr int nwg = (NTOK / BM) * (3072 / BM);
    __device__ __forceinline__ bool next(int i, Unit& u) const {
        const long L = (long)i * G + c; if (L >= nwg) return false;
        int wgid = (int)L; { const int q = nwg / NXCD, r = nwg % NXCD, xcd = wgid % NXCD, off = wgid / NXCD; wgid = (xcd < r ? xcd * (q + 1) : r * (q + 1) + (xcd - r) * q) + off; }
        constexpr int cnN = 3072 / BM, nig = WGM * cnN; const int gid = wgid / nig, rem = wgid % nig, fm = gid * WGM;
        u.pm = fm + (rem % WGM); u.pn = rem / WGM; u.e = 0; u.mrel = 0; u.pnl = u.pn; return true;
    }
    static constexpr bool TABLE = false;
    __device__ __forceinline__ int row_tok(const Unit& u, int row) const { return u.pm * BM + row; }
    __device__ __forceinline__ int row_tok_lds(const Unit& u, int row, const LAS int*) const { return u.pm * BM + row; }
    __device__ __forceinline__ const int* tok_src(const Unit&) const { return nullptr; }
};
struct PanelOrder {
    static constexpr bool GATHER = false; static constexpr bool TABLE = false;
    int nM, nN, G, c;
    __device__ void init(int M, int N, int G_, int c_) { nM = M / BM; nN = N / BM; G = G_; c = c_; }
    __device__ __forceinline__ bool next(int i, Unit& u) const { constexpr int cnN = D / BM; const int p = c + (i / cnN) * G; if (p >= nM) return false; u.pm = p; u.pn = (i + c) % cnN;
        u.e = 0; u.mrel = 0; u.pnl = u.pn; return true; }
    __device__ __forceinline__ int row_tok(const Unit& u, int row) const { return u.pm * BM + row; }
    __device__ __forceinline__ int row_tok_lds(const Unit& u, int row, const LAS int*) const { return u.pm * BM + row; }
    __device__ __forceinline__ const int* tok_src(const Unit&) const { return nullptr; }
};
struct PanelOrderG : PanelOrder { static constexpr bool GATHER = true; };
struct StaticOrderG : StaticOrder { static constexpr bool GATHER = true; };
struct MoeOrder {
    const LAS int* tab; const int* toks; int nN, Tm, nwg, G, c, lgn;
    __device__ void init(const LAS int* tab_, const int* toks_, int nN_, int G_, int c_) { tab = tab_; toks = toks_; nN = nN_; Tm = tab_[32]; nwg = Tm * nN_; G = G_; c = c_; lgn = nN_ == 8 ? 6 : 5; }
    __device__ __forceinline__ bool next(int i, Unit& u) const {
        const long L = (long)i * G + c; if (L >= nwg) return false;
        int wgid = (int)L; { const int q = nwg / NXCD, r = nwg % NXCD, xcd = wgid % NXCD, off = wgid / NXCD; wgid = (xcd < r ? xcd * (q + 1) : r * (q + 1) + (xcd - r) * q) + off; }
        const int gid = wgid >> lgn, rem = wgid & ((1 << lgn) - 1), fm = gid * WGM, gsz = (Tm - fm) < WGM ? (Tm - fm) : WGM;
        int mt, pnl; if (gsz == WGM) { mt = fm + (rem & (WGM - 1)); pnl = rem / WGM; } else { mt = fm + rem % gsz; pnl = rem / gsz; }
        const int ti = __builtin_amdgcn_readfirstlane(tab[(TINFO_OFF - TAB_OFF) / 4 + mt]);
        const int e = ti >> 16;
        u.pm = mt; u.e = e; u.mrel = ti & 0xffff; u.pnl = pnl; u.pn = e * nN + pnl; return true;
    }
    __device__ __forceinline__ const int* tok_src(const Unit& u) const { return toks + (size_t)u.e * CAP + u.mrel * 256; }
    __device__ __forceinline__ int row_tok_lds(const Unit& u, int row, const LAS int* tt) const { const int p = u.mrel * 256 + row, cnt = tab[40 + u.e]; const int t = tt[row]; return p < cnt ? t : 0; }
    __device__ __forceinline__ int row_tok(const Unit& u, int row) const {
        const int p = u.mrel * 256 + row, cnt = tab[40 + u.e];
        const int t = ((const GAS int*)toks)[(size_t)u.e * CAP + (p < cnt ? p : cnt - 1)];
        return p < cnt ? t : 0;
    }
};
template <bool GTH> struct MoeOrderT : MoeOrder { static constexpr bool GATHER = GTH; static constexpr bool TABLE = GTH; };
struct MoeOrderI : MoeOrder { static constexpr bool GATHER = true; static constexpr bool TABLE = false;
    __device__ __forceinline__ int row_tok(const Unit& u, int row) const { return u.pm * BM + row; }
    __device__ __forceinline__ int row_tok_lds(const Unit& u, int row, const LAS int*) const { return u.pm * BM + row; } };

template <class Epi, class Sched, bool ALIGN_EPI, int ESZ>
__device__ __forceinline__ void gemm_phase(LAS unsigned char* lds, const void* Aptr, const void* Btptr, const int Kel, const Sched& S, const Epi& E) {
    const int K = Kel * ESZ / 2;
    const int tid = opaque_tid(), wid = __builtin_amdgcn_readfirstlane(tid >> 6), lane = tid & 63, wr = wid >> 2, wc = wid & 3, fr = lane & 15, fq = lane >> 4;
    const int nt = K / BK;
    unsigned voffA[2], voffB[2];
#pragma unroll
    for (int i = 0; i < 2; ++i) { int R, C; stage_rc(tid * 16 + i * 8192, R, C); const int Rb = Epi::PERM ? ((R & ~31) + perm32(R & 31)) : R; voffA[i] = (unsigned)(R * K + C) * 2u; voffB[i] = (unsigned)(Rb * K + C) * 2u; }
    const size_t kstep = (size_t)(BK * 2);
    const size_t hstep = (size_t)HALF * K * 2;
    const size_t tstep = 2 * hstep;
    const unsigned ldsw = (unsigned)wid * 1024u;
    LAS unsigned char* ldsA = lds + lds_byte(wr * 64 + fr, fq * 8); LAS unsigned char* ldsB = lds + 4 * HTB + lds_byte(wc * 32 + fr, fq * 8);
    asm volatile("" : "+v"(ldsA), "+v"(ldsB));
#define PG8_SA(b, h) (((b) * 2 + (h)) * HTB)
#define PG8_SB(b, h) ((4 + (b) * 2 + (h)) * HTB)
#define PG8_STAGE(bufoff, gbase, voff) do { const char* _gb = (const char*)(gbase); asm volatile("" : "+s"(_gb)); _Pragma("unroll") for (int _i = 0; _i < 2; ++_i) { unsigned _vo = (voff)[_i]; asm volatile("" : "+v"(_vo)); \
        __builtin_amdgcn_global_load_lds((const unsigned*)(_gb + _vo), (LAS unsigned*)(lds + (bufoff) + ldsw + _i * 8192), 16, 0, 0); } } while (0)
#define PG8_LDA(dst, b, h) do { _Pragma("unroll") for (int m = 0; m < 4; ++m) { if constexpr (ESZ == 2) { _Pragma("unroll") for (int k = 0; k < 2; ++k) dst[m][k] = *(const LAS bf16x8*)(ldsA + PG8_SA(b, h) + m * 2048 + k * 1024); } \
        else { dst##8[m] = __builtin_shufflevector(*(const LAS i32x4*)(ldsA + PG8_SA(b, h) + m * 2048), *(const LAS i32x4*)(ldsA + PG8_SA(b, h) + m * 2048 + 1024), 0, 1, 2, 3, 4, 5, 6, 7); } } } while (0)
#define PG8_LDB(dst, b, h) do { _Pragma("unroll") for (int n = 0; n < 2; ++n) { if constexpr (ESZ == 2) { _Pragma("unroll") for (int k = 0; k < 2; ++k) dst[n][k] = *(const LAS bf16x8*)(ldsB + PG8_SA(b, h) + n * 2048 + k * 1024); } \
        else { dst##8[n] = __builtin_shufflevector(*(const LAS i32x4*)(ldsB + PG8_SA(b, h) + n * 2048), *(const LAS i32x4*)(ldsB + PG8_SA(b, h) + n * 2048 + 1024), 0, 1, 2, 3, 4, 5, 6, 7); } } } while (0)
#define PG8_MMA(ai, bj, At, Bt) do { __builtin_amdgcn_s_setprio(1); _Pragma("unroll") for (int m = 0; m < 4; ++m) _Pragma("unroll") for (int n = 0; n < 2; ++n) { if constexpr (ESZ == 2) { _Pragma("unroll") for (int k = 0; k < 2; ++k) \
        acc[ai][bj][m][n] = __builtin_amdgcn_mfma_f32_16x16x32_bf16(Bt[n][k], At[m][k], acc[ai][bj][m][n], 0, 0, 0); } else { \
        acc[ai][bj][m][n] = __builtin_amdgcn_mfma_scale_f32_16x16x128_f8f6f4(Bt##8[n], At##8[m], acc[ai][bj][m][n], 0, 0, 0, 0x7B7B7B7B, 0, 0x7F7F7F7F); } } __builtin_amdgcn_s_setprio(0); } while (0)
#define PG8_WAIT_V(n) asm volatile("s_waitcnt vmcnt(" #n ")" ::: "memory")
#define PG8_WAIT_L(n) asm volatile("s_waitcnt lgkmcnt(" #n ")" ::: "memory")
#define PG8_BAR __builtin_amdgcn_s_barrier()
#define PG8_SCHED __builtin_amdgcn_sched_barrier(0)
#define PG8_AOFFS(dst, u) do { int _t = tid; asm volatile("" : "+v"(_t)); _Pragma("unroll") for (int _i = 0; _i < 2; ++_i) { int _R, _C; stage_rc(_t * 16 + _i * 8192, _R, _C); \
        _Pragma("unroll") for (int _h = 0; _h < 2; ++_h) { const int _tk = S.row_tok(u, _h * HALF + _R); dst[_h][_i] = (unsigned)(_tk * K + _C) * 2u; } } } while (0)
#define PG8_AOFFS_LDS(dst, u) do { int _t = tid; asm volatile("" : "+v"(_t)); _Pragma("unroll") for (int _i = 0; _i < 2; ++_i) { int _R, _C; stage_rc(_t * 16 + _i * 8192, _R, _C); \
        _Pragma("unroll") for (int _h = 0; _h < 2; ++_h) { const int _tk = S.row_tok_lds(u, _h * HALF + _R, toktab); dst[_h][_i] = (unsigned)(_tk * K + _C) * 2u; } } } while (0)
#define PG8_STAGE_A(bufoff, p, h) do { if constexpr (Sched::GATHER) { PG8_STAGE(bufoff, p, ao[h]); } else { PG8_STAGE(bufoff, (p) + (h) * hstep, voffA); } } while (0)
#define PG8_ABASE(u) (Sched::GATHER ? (const char*)Aptr : (const char*)Aptr + (size_t)(u).pm * tstep)
    Unit cur, nxt; int ui = 0;
    if (!S.next(0, cur)) return;
    LAS int* toktab = (LAS int*)(lds + TOKTAB_OFF);
    f32x4 acc[2][2][4][2];
    E.init(acc, cur, wc, fq);
    bf16x8 At[4][2], B0[2][2], B1[2][2]; i32x8 At8[4], B08[2], B18[2];
    unsigned ao[2][2];
    if constexpr (Sched::GATHER) { PG8_AOFFS(ao, cur); }
    const char* cA = PG8_ABASE(cur); const char* cB = (const char*)Btptr + (size_t)cur.pn * tstep;
    PG8_STAGE(PG8_SB(0, 0), cB, voffB); PG8_STAGE(PG8_SB(0, 1), cB + hstep, voffB); PG8_STAGE_A(PG8_SA(0, 0), cA, 0); PG8_STAGE_A(PG8_SA(0, 1), cA, 1);
    if (wr == 1) PG8_BAR;
    PG8_WAIT_V(2); PG8_BAR;
    PG8_STAGE(PG8_SB(1, 0), cB + kstep, voffB); PG8_STAGE_A(PG8_SA(1, 0), cA + kstep, 0); PG8_STAGE(PG8_SB(1, 1), cB + hstep + kstep, voffB);
    PG8_WAIT_V(6); PG8_BAR;
    for (;;) {
        const bool has_next = S.next(ui + 1, nxt);
        const char* nA = has_next ? PG8_ABASE(nxt) : cA; const char* nB = has_next ? (const char*)Btptr + (size_t)nxt.pn * tstep : cB;
        if constexpr (Sched::GATHER && Sched::TABLE) { if (has_next && wid < 4)
            __builtin_amdgcn_global_load_lds((const unsigned*)(S.tok_src(nxt) + wid * 64 + lane), (LAS unsigned*)(toktab + wid * 64), 4, 0, 0); }
#pragma nounroll
        for (int t = 0; t < nt; t += 2) {
            const bool last = (t == nt - 2);
            const char* a1 = cA + (size_t)(t + 1) * kstep;
            const char* a2 = last ? nA : cA + (size_t)(t + 2) * kstep; const char* b2 = last ? nB : cB + (size_t)(t + 2) * kstep;
            const char* a3 = a2 + kstep; const char* b3 = b2 + kstep;
            PG8_LDB(B0, 0, 0); PG8_LDB(B1, 0, 1); PG8_SCHED; PG8_LDA(At, 0, 0); PG8_STAGE_A(PG8_SA(1, 1), a1, 1);
            if constexpr (Sched::GATHER) { if (last && has_next) { PG8_AOFFS_LDS(ao, nxt); } }
            PG8_WAIT_V(8); PG8_WAIT_L(0); PG8_BAR; PG8_MMA(0, 0, At, B0); PG8_MMA(0, 1, At, B1); PG8_BAR; PG8_SCHED;
            PG8_LDA(At, 0, 1); PG8_STAGE(PG8_SB(0, 0), b2, voffB); PG8_STAGE(PG8_SB(0, 1), b2 + hstep, voffB); PG8_STAGE_A(PG8_SA(0, 0), a2, 0);
            PG8_WAIT_V(8); PG8_WAIT_L(0); PG8_BAR; PG8_MMA(1, 0, At, B0); PG8_MMA(1, 1, At, B1); PG8_BAR; PG8_SCHED;
            PG8_LDB(B0, 1, 0); PG8_LDB(B1, 1, 1); PG8_SCHED; PG8_LDA(At, 1, 0); PG8_STAGE_A(PG8_SA(0, 1), a2, 1);
            PG8_WAIT_V(8); PG8_WAIT_L(0); PG8_BAR; PG8_MMA(0, 0, At, B0); PG8_MMA(0, 1, At, B1); PG8_BAR; PG8_SCHED;
            PG8_LDA(At, 1, 1); PG8_STAGE(PG8_SB(1, 0), b3, voffB); PG8_STAGE(PG8_SB(1, 1), b3 + hstep, voffB); PG8_STAGE_A(PG8_SA(1, 0), a3, 0);
            PG8_WAIT_V(8); PG8_WAIT_L(0); PG8_BAR; PG8_MMA(1, 0, At, B0); PG8_MMA(1, 1, At, B1); PG8_BAR; PG8_SCHED;
        }
        if constexpr (ALIGN_EPI) { if (wr == 0) PG8_BAR; }
        typename Epi::Pre pre; if (has_next) E.prefetch(pre, nxt);
        E(acc, cur, wr, wc, fr, fq);
        if (!has_next) break;
        E.init2(acc, pre);
        cur = nxt; cA = nA; cB = nB; ++ui;
        if constexpr (ALIGN_EPI) { if (wr == 1) PG8_BAR; }
    }
    PG8_WAIT_V(0);
    if constexpr (!ALIGN_EPI) { if (wr == 0) PG8_BAR; }
    PG8_BAR;
#undef PG8_SA
#undef PG8_SB
#undef PG8_STAGE
#undef PG8_LDA
#undef PG8_LDB
#undef PG8_MMA
#undef PG8_WAIT_V
#undef PG8_WAIT_L
#undef PG8_BAR
#undef PG8_SCHED
#undef PG8_AOFFS
#undef PG8_AOFFS_LDS
#undef PG8_STAGE_A
#undef PG8_ABASE
}

struct EpiConvIn {
    static constexpr bool PERM = true;
    __device__ __forceinline__ void init(f32x4 (&acc)[2][2][4][2], const Unit&, int, int) const {
#pragma unroll
        for (int a = 0; a < 2; ++a)
#pragma unroll
            for (int b = 0; b < 2; ++b)
#pragma unroll
                for (int m = 0; m < 4; ++m)
#pragma unroll
                    for (int n = 0; n < 2; ++n) acc[a][b][m][n] = (f32x4){0.f, 0.f, 0.f, 0.f};
    }
    struct Pre {};
    __device__ __forceinline__ void prefetch(Pre&, const Unit&) const {}
    __device__ __forceinline__ void init2(f32x4 (&acc)[2][2][4][2], const Pre&) const { Unit u{}; init(acc, u, 0, 0); }
    bf16_t* Bb; bf16_t* Vb;
    __device__ __forceinline__ void operator()(const f32x4 (&acc)[2][2][4][2], const Unit& u, int wr, int wc, int fr, int fq) const {
        int row0 = u.pm * BM + wr * 64 + fr; asm volatile("" : "+v"(row0));
        if (u.pn < 8) {
            const int col0 = u.pn * 128 + wc * 32 + 8 * fq;
#pragma unroll
            for (int ai = 0; ai < 2; ++ai)
#pragma unroll
                for (int m = 0; m < 4; ++m) {
                    const f32x4 v0 = acc[ai][0][m][0] * acc[ai][1][m][0], v1 = acc[ai][0][m][1] * acc[ai][1][m][1];
                    u32x4 w; w.x = cvt_pk_bf16(v0[0], v0[1]); w.y = cvt_pk_bf16(v0[2], v0[3]); w.z = cvt_pk_bf16(v1[0], v1[1]); w.w = cvt_pk_bf16(v1[2], v1[3]);
                    *(GAS u32x4*)(Vb + (size_t)(row0 + ai * HALF + m * 16) * D + col0) = w; }
        } else {
            const int col0 = (u.pn - 8) * 256 + wc * 32 + 8 * fq;
#pragma unroll
            for (int ai = 0; ai < 2; ++ai)
#pragma unroll
                for (int m = 0; m < 4; ++m)
#pragma unroll
                    for (int bj = 0; bj < 2; ++bj) {
                        const f32x4 v0 = acc[ai][bj][m][0], v1 = acc[ai][bj][m][1];
                        u32x4 w; w.x = cvt_pk_bf16(v0[0], v0[1]); w.y = cvt_pk_bf16(v0[2], v0[3]); w.z = cvt_pk_bf16(v1[0], v1[1]); w.w = cvt_pk_bf16(v1[2], v1[3]);
                        *(GAS u32x4*)(Bb + (size_t)(row0 + ai * HALF + m * 16) * D + col0 + bj * HALF) = w; }
        }
    }
};
struct EpiQKV {
    static constexpr bool PERM = true;
    __device__ __forceinline__ void init(f32x4 (&acc)[2][2][4][2], const Unit&, int, int) const {
#pragma unroll
        for (int a = 0; a < 2; ++a)
#pragma unroll
            for (int b = 0; b < 2; ++b)
#pragma unroll
                for (int m = 0; m < 4; ++m)
#pragma unroll
                    for (int n = 0; n < 2; ++n) acc[a][b][m][n] = (f32x4){0.f, 0.f, 0.f, 0.f};
    }
    struct Pre {};
    __device__ __forceinline__ void prefetch(Pre&, const Unit&) const {}
    __device__ __forceinline__ void init2(f32x4 (&acc)[2][2][4][2], const Pre&) const { Unit u{}; init(acc, u, 0, 0); }
    bf16_t* Qb; bf16_t* Kb; bf16_t* Vb; const LAS float* gains;
    __device__ __forceinline__ void operator()(const f32x4 (&acc)[2][2][4][2], const Unit& u, int wr, int wc, int fr, int fq) const {
        const int t_ = opaque_tid(), l_ = t_ & 63, w_ = __builtin_amdgcn_readfirstlane(t_ >> 6);
        wr = w_ >> 2; wc = w_ & 3; fr = l_ & 15; fq = l_ >> 4;
        const int part = u.pn >> 2, head = (u.pn & 3) * 4 + wc;
        const int row0 = u.pm * BM + wr * 64 + fr; const int col0 = head * HD + 8 * fq;
        if (part < 2) {
            const LAS float* gp = gains + part * 64;
            f32x4 gv[2][2];
#pragma unroll
            for (int bj = 0; bj < 2; ++bj)
#pragma unroll
                for (int n = 0; n < 2; ++n) gv[bj][n] = *(const LAS f32x4*)(gp + 32 * bj + 8 * fq + 4 * n);
            bf16_t* dst = part == 0 ? Qb : Kb;
#pragma unroll
            for (int ai = 0; ai < 2; ++ai)
#pragma unroll
                for (int m = 0; m < 4; ++m) {
                    float ss = 0.f;
#pragma unroll
                    for (int bj = 0; bj < 2; ++bj)
#pragma unroll
                        for (int n = 0; n < 2; ++n) { const f32x4 x = acc[ai][bj][m][n]; ss += (x[0] * x[0] + x[1] * x[1]) + (x[2] * x[2] + x[3] * x[3]); }
                    { const auto r1 = __builtin_amdgcn_permlane16_swap(__float_as_uint(ss), __float_as_uint(ss), false, false); ss = __uint_as_float(r1[0]) + __uint_as_float(r1[1]); }
                    { const auto r2 = __builtin_amdgcn_permlane32_swap(__float_as_uint(ss), __float_as_uint(ss), false, false); ss = __uint_as_float(r2[0]) + __uint_as_float(r2[1]); }
                    const float rinv = rsqrtf(ss * (1.0f / 64.0f) + EPS);
#pragma unroll
                    for (int bj = 0; bj < 2; ++bj) {
                        const f32x4 v0 = acc[ai][bj][m][0] * rinv * gv[bj][0], v1 = acc[ai][bj][m][1] * rinv * gv[bj][1];
                        u32x4 w; w.x = cvt_pk_bf16(v0[0], v0[1]); w.y = cvt_pk_bf16(v0[2], v0[3]); w.z = cvt_pk_bf16(v1[0], v1[1]); w.w = cvt_pk_bf16(v1[2], v1[3]);
                        *(GAS u32x4*)(dst + (size_t)(row0 + ai * HALF + m * 16) * D + col0 + 32 * bj) = w; }
                }
        } else {
#pragma unroll
            for (int ai = 0; ai < 2; ++ai)
#pragma unroll
                for (int m = 0; m < 4; ++m)
#pragma unroll
                    for (int bj = 0; bj < 2; ++bj) {
                        const f32x4 v0 = acc[ai][bj][m][0], v1 = acc[ai][bj][m][1];
                        u32x4 w; w.x = cvt_pk_bf16(v0[0], v0[1]); w.y = cvt_pk_bf16(v0[2], v0[3]); w.z = cvt_pk_bf16(v1[0], v1[1]); w.w = cvt_pk_bf16(v1[2], v1[3]);
                        *(GAS u32x4*)(Vb + (size_t)(row0 + ai * HALF + m * 16) * D + col0 + 32 * bj) = w; }
        }
    }
};
template <bool XF32> struct EpiResidT {
    static constexpr bool PERM = true;
    __device__ __forceinline__ void init(f32x4 (&acc)[2][2][4][2], const Unit&, int, int) const {
#pragma unroll
        for (int a = 0; a < 2; ++a)
#pragma unroll
            for (int b = 0; b < 2; ++b)
#pragma unroll
                for (int m = 0; m < 4; ++m)
#pragma unroll
                    for (int n = 0; n < 2; ++n) acc[a][b][m][n] = (f32x4){0.f, 0.f, 0.f, 0.f};
    }
    struct Pre {};
    __device__ __forceinline__ void prefetch(Pre&, const Unit&) const {}
    __device__ __forceinline__ void init2(f32x4 (&acc)[2][2][4][2], const Pre&) const { Unit u{}; init(acc, u, 0, 0); }
    const void* xin; bf16_t* xout; const float* gt;
    __device__ __forceinline__ void operator()(const f32x4 (&acc)[2][2][4][2], const Unit& u, int wr, int wc, int fr, int fq) const {
        int row0 = u.pm * BM + wr * 64 + fr; asm volatile("" : "+v"(row0)); const int col0 = u.pn * BM + wc * 32 + 8 * fq;
        const float* gp = gt + (size_t)((u.pm * BM) / SEQ) * 6144 + col0;
        f32x4 gv[2][2];
#pragma unroll
        for (int bj = 0; bj < 2; ++bj)
#pragma unroll
            for (int n = 0; n < 2; ++n) gv[bj][n] = *(const GAS f32x4*)(gp + bj * HALF + 4 * n);
#pragma unroll
        for (int ai = 0; ai < 2; ++ai) {
            f32x4 xv[4][2][2];
#pragma unroll
            for (int mm = 0; mm < 4; ++mm) { const size_t off = (size_t)(row0 + ai * HALF + mm * 16) * D + col0;
#pragma unroll
                for (int bj = 0; bj < 2; ++bj) {
                    if constexpr (XF32) { xv[mm][bj][0] = *(const GAS f32x4*)((const float*)xin + off + bj * HALF); xv[mm][bj][1] = *(const GAS f32x4*)((const float*)xin + off + bj * HALF + 4); }
                    else { const u32x4 w = *(const GAS u32x4*)((const bf16_t*)xin + off + bj * HALF);
                           xv[mm][bj][0] = (f32x4){bf_lo(w.x), bf_hi(w.x), bf_lo(w.y), bf_hi(w.y)}; xv[mm][bj][1] = (f32x4){bf_lo(w.z), bf_hi(w.z), bf_lo(w.w), bf_hi(w.w)}; } } }
#pragma unroll
            for (int mm = 0; mm < 4; ++mm) { const size_t off = (size_t)(row0 + ai * HALF + mm * 16) * D + col0;
#pragma unroll
                for (int bj = 0; bj < 2; ++bj) { const f32x4 v0 = xv[mm][bj][0] + gv[bj][0] * acc[ai][bj][mm][0], v1 = xv[mm][bj][1] + gv[bj][1] * acc[ai][bj][mm][1];
                    u32x4 w; w.x = cvt_pk_bf16(v0[0], v0[1]); w.y = cvt_pk_bf16(v0[2], v0[3]); w.z = cvt_pk_bf16(v1[0], v1[1]); w.w = cvt_pk_bf16(v1[2], v1[3]);
                    *(GAS u32x4*)(xout + off + bj * HALF) = w; } }
            asm volatile("" ::: "memory"); }
    }
};
struct EpiMoe1 {
    static constexpr bool PERM = true;
    unsigned char* act; const float* b1;
    struct Pre { f32x4 bg[2], bu[2]; };
    __device__ __forceinline__ void prefetch(Pre& p, const Unit& u) const {
        const int t_ = opaque_tid(); const int wc_ = __builtin_amdgcn_readfirstlane(t_ >> 6) & 3, fq_ = (t_ & 63) >> 4;
        const float* bp = b1 + (size_t)u.e * 2048 + u.pnl * 128 + wc_ * 32 + 8 * fq_;
#pragma unroll
        for (int n = 0; n < 2; ++n) { p.bg[n] = *(const GAS f32x4*)(bp + 4 * n); p.bu[n] = *(const GAS f32x4*)(bp + 1024 + 4 * n); }
    }
    __device__ __forceinline__ void init2(f32x4 (&acc)[2][2][4][2], const Pre& p) const {
#pragma unroll
        for (int n = 0; n < 2; ++n)
#pragma unroll
            for (int a = 0; a < 2; ++a)
#pragma unroll
                for (int m = 0; m < 4; ++m) { acc[a][0][m][n] = p.bg[n]; acc[a][1][m][n] = p.bu[n]; }
    }
    __device__ __forceinline__ void init(f32x4 (&acc)[2][2][4][2], const Unit& u, int, int) const { Pre p; prefetch(p, u); init2(acc, p); }
    __device__ __forceinline__ void operator()(const f32x4 (&acc)[2][2][4][2], const Unit& u, int wr, int wc, int fr, int fq) const {
        int row0 = u.pm * BM + wr * 64 + fr + ((fq & 1) ? 16 : 0); asm volatile("" : "+v"(row0)); const int col0 = u.pnl * 128 + wc * 32 + 8 * (fq & 2);
#pragma unroll
        for (int ai = 0; ai < 2; ++ai)
#pragma unroll
            for (int mp = 0; mp < 2; ++mp) {
                u32x2 w[2];
#pragma unroll
                for (int mm = 0; mm < 2; ++mm) { const int m = 2 * mp + mm;
                    f32x2 o[4], gh[4], p[4], d[4];
#pragma unroll
                    for (int q = 0; q < 4; ++q) { const int n = q >> 1, hh = q & 1;
                        gh[q].x = __builtin_amdgcn_fmed3f(acc[ai][0][m][n][2 * hh], -40.0f, 7.0f); gh[q].y = __builtin_amdgcn_fmed3f(acc[ai][0][m][n][2 * hh + 1], -40.0f, 7.0f);
                        f32x2 uh; uh.x = __builtin_amdgcn_fmed3f(acc[ai][1][m][n][2 * hh], -7.0f, 7.0f); uh.y = __builtin_amdgcn_fmed3f(acc[ai][1][m][n][2 * hh + 1], -7.0f, 7.0f);
                        const f32x2 t = gh[q] * (-1.702f * 1.4426950408889634f);
                        f32x2 e; e.x = __builtin_amdgcn_exp2f(t.x); e.y = __builtin_amdgcn_exp2f(t.y);
                        d[q] = e + 1.0f; p[q] = (uh + 1.0f) * gh[q]; }
#pragma unroll
                    for (int q = 0; q < 2; ++q) { const f32x2 dd = d[q] * d[q + 2];
                        f32x2 r; r.x = __builtin_amdgcn_rcpf(dd.x); r.y = __builtin_amdgcn_rcpf(dd.y);
                        o[q] = p[q] * (d[q + 2] * r); o[q + 2] = p[q + 2] * (d[q] * r); }
                    w[mm].x = cvt_pk4_fp8(o[0].x, o[0].y, o[1].x, o[1].y); w[mm].y = cvt_pk4_fp8(o[2].x, o[2].y, o[3].x, o[3].y); }
                const auto rx = __builtin_amdgcn_permlane16_swap(w[0].x, w[1].x, false, false), ry = __builtin_amdgcn_permlane16_swap(w[0].y, w[1].y, false, false);
                u32x4 v; v.x = rx[0]; v.y = ry[0]; v.z = rx[1]; v.w = ry[1];
                *(GAS u32x4*)(act + (size_t)(row0 + ai * HALF + mp * 32) * FF + col0) = v; }
    }
};
struct EpiMoe2 {
    static constexpr bool PERM = true;
    unsigned char* Y; const float* b2; const float* gl; const LAS int* tab;
    struct Pre { f32x4 bv[2][2]; };
    __device__ __forceinline__ void prefetch(Pre& p, const Unit& u) const {
        const int t_ = opaque_tid(); const int wc_ = __builtin_amdgcn_readfirstlane(t_ >> 6) & 3, fq_ = (t_ & 63) >> 4;
        const float* bp = b2 + (size_t)u.e * D + u.pnl * BM + wc_ * 32 + 8 * fq_;
#pragma unroll
        for (int bj = 0; bj < 2; ++bj)
#pragma unroll
            for (int n = 0; n < 2; ++n) p.bv[bj][n] = *(const GAS f32x4*)(bp + bj * HALF + 4 * n);
    }
    __device__ __forceinline__ void init2(f32x4 (&acc)[2][2][4][2], const Pre& p) const {
#pragma unroll
        for (int bj = 0; bj < 2; ++bj)
#pragma unroll
            for (int n = 0; n < 2; ++n)
#pragma unroll
                for (int a = 0; a < 2; ++a)
#pragma unroll
                    for (int m = 0; m < 4; ++m) acc[a][bj][m][n] = p.bv[bj][n];
    }
    __device__ __forceinline__ void init(f32x4 (&acc)[2][2][4][2], const Unit& u, int, int) const { Pre p; prefetch(p, u); init2(acc, p); }
    __device__ __forceinline__ void operator()(const f32x4 (&acc)[2][2][4][2], const Unit& u, int wr, int wc, int fr, int fq) const {
        const int t_ = opaque_tid(), l_ = t_ & 63, w_ = __builtin_amdgcn_readfirstlane(t_ >> 6);
        const int rl0 = (w_ >> 2) * 64 + (l_ & 15); const int col0 = u.pnl * BM + (w_ & 3) * 32 + 8 * ((l_ >> 4) & 2);
        unsigned char* yp = Y + (size_t)u.pm * BM * D + col0;
#pragma unroll
        for (int ai = 0; ai < 2; ++ai)
#pragma unroll
            for (int mp = 0; mp < 2; ++mp) {
                const int rl = rl0 + ai * HALF + mp * 32 + ((l_ & 16) ? 16 : 0);
#pragma unroll
                for (int bj = 0; bj < 2; ++bj) {
                    u32x2 w[2];
#pragma unroll
                    for (int mm = 0; mm < 2; ++mm) { const int m = 2 * mp + mm; const f32x4 v0 = acc[ai][bj][m][0], v1 = acc[ai][bj][m][1];
                        w[mm].x = cvt_pk4_fp8(v0[0], v0[1], v0[2], v0[3]); w[mm].y = cvt_pk4_fp8(v1[0], v1[1], v1[2], v1[3]); }
                    const auto rx = __builtin_amdgcn_permlane16_swap(w[0].x, w[1].x, false, false), ry = __builtin_amdgcn_permlane16_swap(w[0].y, w[1].y, false, false);
                    u32x4 v; v.x = rx[0]; v.y = ry[0]; v.z = rx[1]; v.w = ry[1];
                    *(GAS u32x4*)(yp + (size_t)rl * D + bj * HALF) = v; }
            }
    }
};
}

constexpr int NWAVES = 8;
struct Args {
    const float* x; const float* c; const float* norm1_g; const float* norm2_g; const float* ada_w; const float* ada_b;
    const float* conv_w_in; const float* conv_w; const float* conv_w_out; const float* attn_w_qkv; const float* attn_q_g; const float* attn_k_g; const float* attn_w_o;
    const float* router_w; const float* router_b; const float* moe_w1; const float* moe_b1; const float* moe_w2; const float* moe_b2;
    float* out; unsigned char* ws;
};

__device__ __forceinline__ void transpose_item(const float* W, int K, int N, bf16_t* WT, int d0, int n0, int kb, LAS float* scr, int lane) {
    const int k0 = 64 * kb;
    float wv[32];
#pragma unroll
    for (int i = 0; i < 32; ++i) wv[i] = __builtin_nontemporal_load(W + (size_t)(k0 + 2 * i + (lane >> 5)) * N + n0 + (lane & 31));
#pragma unroll
    for (int i = 0; i < 32; ++i) scr[(2 * i + (lane >> 5)) * 33 + (lane & 31)] = wv[i];
    LDS_WAIT(); asm volatile("" ::: "memory");
    const int c = lane & 7;
#pragma unroll
    for (int j = 0; j < 4; ++j) { const int n = (lane >> 3) + 8 * j; const LAS float* s = scr + (8 * c) * 33 + n;
        u32x4 o; o.x = cvt_pk_bf16(s[0 * 33], s[1 * 33]); o.y = cvt_pk_bf16(s[2 * 33], s[3 * 33]); o.z = cvt_pk_bf16(s[4 * 33], s[5 * 33]); o.w = cvt_pk_bf16(s[6 * 33], s[7 * 33]);
        __builtin_nontemporal_store(o, (GAS u32x4*)(WT + (size_t)(d0 + n) * K + k0 + 8 * c)); }
    LDS_WAIT(); asm volatile("" ::: "memory");
}
__device__ __forceinline__ void transpose_item_fp8(const float* W, int K, int N, unsigned char* WT, int d0, int n0, int kb, LAS float* scr, int lane) {
    const int k0 = 64 * kb;
    float wv[32];
#pragma unroll
    for (int i = 0; i < 32; ++i) wv[i] = __builtin_nontemporal_load(W + (size_t)(k0 + 2 * i + (lane >> 5)) * N + n0 + (lane & 31));
#pragma unroll
    for (int i = 0; i < 32; ++i) scr[(2 * i + (lane >> 5)) * 33 + (lane & 31)] = wv[i] * 16.0f;
    LDS_WAIT(); asm volatile("" ::: "memory");
    const int c = lane & 7;
#pragma unroll
    for (int j = 0; j < 4; ++j) { const int n = (lane >> 3) + 8 * j; const LAS float* s = scr + (8 * c) * 33 + n;
        u32x2 o; o.x = cvt_pk4_fp8(s[0 * 33], s[1 * 33], s[2 * 33], s[3 * 33]); o.y = cvt_pk4_fp8(s[4 * 33], s[5 * 33], s[6 * 33], s[7 * 33]);
        __builtin_nontemporal_store(o, (GAS u32x2*)(WT + (size_t)(d0 + n) * K + k0 + 8 * c)); }
    LDS_WAIT(); asm volatile("" ::: "memory");
}
__device__ __forceinline__ int src_convin(int g) { if (g < 64) { const int t = g >> 3, bj = (g & 7) >> 2, jj = g & 3; return (1 + bj) * 1024 + 128 * t + 32 * jj; } return 32 * (g - 64); }
__device__ __forceinline__ int src_qkv(int g) { const int pn = g >> 3, bj = (g & 7) >> 2, wc = g & 3; return (pn >> 2) * 1024 + ((pn & 3) * 4 + wc) * 64 + 32 * bj; }
__device__ __forceinline__ int src_w1(int g) { const int pn = g >> 3, bj = (g & 7) >> 2, jj = g & 3; return bj * 1024 + 128 * pn + 32 * jj; }

__device__ __forceinline__ void prologue(const Args& a, LAS unsigned char* lds, int vcu, int G) {
    const int tid = opaque_tid(), lane = tid & 63, wave = __builtin_amdgcn_readfirstlane(tid >> 6);
    unsigned char* ws = a.ws;
    {
        LAS float* cact = (LAS float*)lds;
        LAS float* red = (LAS float*)(lds + 65536);
        for (int i = tid; i < NB * D; i += NWAVES * 64) { const float v = a.c[i]; cact[i] = v / (1.0f + __expf(-v)); }
        __syncthreads();
        float* mod = (float*)(ws + WS_MOD);
        constexpr int NITEM = DEPTH * 6144 / 64;
        for (int it = vcu; it < NITEM; it += G) {
            const int l = it / 96, j0 = (it % 96) * 64;
            const float* wp = a.ada_w + (size_t)l * D * 6144 + (size_t)(128 * wave) * 6144 + j0 + lane;
            float accv[16];
#pragma unroll
            for (int b = 0; b < 16; ++b) accv[b] = 0.f;
            const float* wb = (const float*)opaque_ptr((unsigned char*)(a.ada_w + (size_t)l * D * 6144 + (size_t)(128 * wave) * 6144 + j0));
#pragma nounroll
            for (int d16 = 0; d16 < 8; ++d16) {
                float w16[16];
#pragma unroll
                for (int q = 0; q < 16; ++q) w16[q] = __builtin_nontemporal_load((const GAS float*)wb + (size_t)(16 * d16 + q) * 6144 + lane);
#pragma unroll
                for (int q4 = 0; q4 < 4; ++q4)
#pragma unroll
                    for (int b = 0; b < 16; ++b) { const f32x4 cv = *(const LAS f32x4*)(cact + b * D + 128 * wave + 16 * d16 + 4 * q4);
                        accv[b] += cv[0] * w16[4 * q4] + cv[1] * w16[4 * q4 + 1] + cv[2] * w16[4 * q4 + 2] + cv[3] * w16[4 * q4 + 3]; }
            }
#pragma unroll
            for (int b = 0; b < 16; ++b) red[(wave * 16 + b) * 64 + lane] = accv[b];
            __syncthreads();
            for (int o = tid; o < 16 * 64; o += NWAVES * 64) { const int b = o >> 6, j = o & 63; float s = a.ada_b[l * 6144 + j0 + j];
#pragma unroll
                for (int w = 0; w < 8; ++w) s += red[(w * 16 + b) * 64 + j];
                ((GAS float*)mod)[((size_t)l * NB + b) * 6144 + j0 + j] = s; }
            __syncthreads();
        }
    }
    {
        LAS float* scr = (LAS float*)(lds + wave * 16384);
        const int gw = vcu * NWAVES + wave, NGW = G * NWAVES;
        constexpr int I_CIN = 96 * 16, I_SQ = 32 * 16, I_R = 16, I_W1 = 64 * 16, I_W2 = 32 * 16;
        constexpr int N_SMALL = 2 * I_CIN + 2 * I_SQ + 2 * I_CIN + 2 * I_SQ + 4 * I_R;
        constexpr int N_W1 = DEPTH * NE * I_W1, N_W2 = DEPTH * NE * I_W2;
        constexpr int NITEMS = N_SMALL + N_W1 + N_W2;
        for (int it = gw; it < NITEMS; it += NGW) {
            int r = it;
            if (r < N_SMALL) {
                if (r < 2 * I_CIN) { const int j = r / I_CIN, q = r % I_CIN, g = q >> 4, kb = q & 15; transpose_item(a.conv_w_in + (size_t)j * D * 3072, D, 3072, (bf16_t*)(ws + WS_WCIN) + (size_t)j * 3072 * D, 32 * g, src_convin(g), kb, scr, lane); continue; } r -= 2 * I_CIN;
                if (r < 2 * I_SQ) { const int j = r / I_SQ, q = r % I_SQ, g = q >> 4, kb = q & 15; transpose_item_fp8(a.conv_w_out + (size_t)j * D * D, D, D, ws + WS_WCOUT + (size_t)j * D * D, 32 * g, 32 * g, kb, scr, lane); continue; } r -= 2 * I_SQ;
                if (r < 2 * I_CIN) { const int j = r / I_CIN, q = r % I_CIN, g = q >> 4, kb = q & 15; transpose_item_fp8(a.attn_w_qkv + (size_t)j * D * 3072, D, 3072, ws + WS_WQKV + (size_t)j * 3072 * D, 32 * g, src_qkv(g), kb, scr, lane); continue; } r -= 2 * I_CIN;
                if (r < 2 * I_SQ) { const int j = r / I_SQ, q = r % I_SQ, g = q >> 4, kb = q & 15; transpose_item_fp8(a.attn_w_o + (size_t)j * D * D, D, D, ws + WS_WO + (size_t)j * D * D, 32 * g, 32 * g, kb, scr, lane); continue; } r -= 2 * I_SQ;
                { const int l = r / I_R, kb = r % I_R; transpose_item(a.router_w + (size_t)l * D * NE, D, NE, (bf16_t*)(ws + WS_WR) + (size_t)l * NE * D, 0, 0, kb, scr, lane); continue; }
            }
            r -= N_SMALL;
            if (r < N_W1) { const int mtx = r / I_W1, q = r % I_W1, g = q >> 4, kb = q & 15; transpose_item_fp8(a.moe_w1 + (size_t)mtx * D * 2048, D, 2048, ws + WS_W1 + (size_t)mtx * 2048 * D, 32 * g, src_w1(g), kb, scr, lane); continue; }
            r -= N_W1;
            { const int mtx = r / I_W2, q = r % I_W2, g = q >> 4, kb = q & 15; transpose_item_fp8(a.moe_w2 + (size_t)mtx * FF * D, FF, D, ws + WS_W2 + (size_t)mtx * D * FF, 32 * g, 32 * g, kb, scr, lane); }
        }
    }
}

__device__ __forceinline__ void norm_phase(const float* __restrict__ x, const float* g, const float* modl  , int shoff, int scoff, bf16_t* __restrict__ h, unsigned char* __restrict__ h8, int vcu, int G) {
    const int tid = opaque_tid(), lane = tid & 63, gw = vcu * NWAVES + __builtin_amdgcn_readfirstlane(tid >> 6), NGW = G * NWAVES;
    for (int w = gw; w < NTOK / 32; w += NGW) {
        const int row0 = w * 32, b = row0 / SEQ;
        const float* sc = modl + (size_t)b * 6144 + scoff; const float* sh = modl + (size_t)b * 6144 + shoff;
        f32x4 av[4], sv[4];
#pragma unroll
        for (int j = 0; j < 4; ++j) { const int cidx = 4 * lane + 256 * j; av[j] = *(const GAS f32x4*)(g + cidx) * (*(const GAS f32x4*)(sc + cidx) + 1.0f); sv[j] = *(const GAS f32x4*)(sh + cidx); }
#pragma nounroll
        for (int r = 0; r < 32; r += 4) {
            f32x4 v[4][4];
#pragma unroll
            for (int q = 0; q < 4; ++q) { const GAS f32x4* xr = (const GAS f32x4*)(x + (size_t)(row0 + r + q) * D) + lane;
#pragma unroll
                for (int j = 0; j < 4; ++j) v[q][j] = xr[64 * j]; }
#pragma unroll
            for (int q = 0; q < 4; ++q) {
                float s = 0.f;
#pragma unroll
                for (int j = 0; j < 4; ++j) s += (v[q][j].x * v[q][j].x + v[q][j].y * v[q][j].y) + (v[q][j].z * v[q][j].z + v[q][j].w * v[q][j].w);
                const float rinv = rsqrtf(wave_sum(s) * (1.0f / D) + EPS);
                GAS u32x2* o8 = (GAS u32x2*)(h + (size_t)(row0 + r + q) * D) + lane; GAS unsigned* o4 = (GAS unsigned*)(h8 + (size_t)(row0 + r + q) * D) + lane;
#pragma unroll
                for (int j = 0; j < 4; ++j) { const f32x4 y = v[q][j] * rinv * av[j] + sv[j]; u32x2 w2; w2.x = cvt_pk_bf16(y.x, y.y); w2.y = cvt_pk_bf16(y.z, y.w); o8[64 * j] = w2; if (h8) o4[64 * j] = cvt_pk4_fp8(y.x, y.y, y.z, y.w); }
            }
        }
    }
}
__device__ __forceinline__ void conv_phase(const bf16_t* __restrict__ Bb, const bf16_t* __restrict__ Vb, const float* cw  , unsigned char* __restrict__ Zb, int vcu, int G) {
    const int tid = opaque_tid();
    const int cg = tid & 127, sub = tid >> 7, c0 = cg * 8;
    float w0[8], w1[8], w2[8];
#pragma unroll
    for (int i = 0; i < 8; ++i) { w0[i] = cw[c0 + i]; w1[i] = cw[D + c0 + i]; w2[i] = cw[2 * D + c0 + i]; }
    for (int blk = vcu; blk < NTOK / 256; blk += G) {
        const int t0 = blk * 256 + sub * 64;
        float p1[8], p2[8];
        if ((t0 % SEQ) == 0) {
#pragma unroll
            for (int i = 0; i < 8; ++i) { p1[i] = 0.f; p2[i] = 0.f; }
        } else {
            const u32x4 a1 = *(const GAS u32x4*)(Vb + (size_t)(t0 - 1) * D + c0), a2 = *(const GAS u32x4*)(Vb + (size_t)(t0 - 2) * D + c0);
            p1[0] = bf_lo(a1.x); p1[1] = bf_hi(a1.x); p1[2] = bf_lo(a1.y); p1[3] = bf_hi(a1.y); p1[4] = bf_lo(a1.z); p1[5] = bf_hi(a1.z); p1[6] = bf_lo(a1.w); p1[7] = bf_hi(a1.w);
            p2[0] = bf_lo(a2.x); p2[1] = bf_hi(a2.x); p2[2] = bf_lo(a2.y); p2[3] = bf_hi(a2.y); p2[4] = bf_lo(a2.z); p2[5] = bf_hi(a2.z); p2[6] = bf_lo(a2.w); p2[7] = bf_hi(a2.w);
        }
#pragma nounroll
        for (int t = t0; t < t0 + 64; t += 4) {
            u32x4 vv4[4], bb4[4];
#pragma unroll
            for (int q = 0; q < 4; ++q) { vv4[q] = __builtin_nontemporal_load((const GAS u32x4*)(Vb + (size_t)(t + q) * D + c0)); bb4[q] = __builtin_nontemporal_load((const GAS u32x4*)(Bb + (size_t)(t + q) * D + c0)); }
#pragma unroll
            for (int q = 0; q < 4; ++q) {
                const u32x4 vv = vv4[q], bb = bb4[q];
                float v[8], bg[8], z[8];
                v[0] = bf_lo(vv.x); v[1] = bf_hi(vv.x); v[2] = bf_lo(vv.y); v[3] = bf_hi(vv.y); v[4] = bf_lo(vv.z); v[5] = bf_hi(vv.z); v[6] = bf_lo(vv.w); v[7] = bf_hi(vv.w);
                bg[0] = bf_lo(bb.x); bg[1] = bf_hi(bb.x); bg[2] = bf_lo(bb.y); bg[3] = bf_hi(bb.y); bg[4] = bf_lo(bb.z); bg[5] = bf_hi(bb.z); bg[6] = bf_lo(bb.w); bg[7] = bf_hi(bb.w);
#pragma unroll
                for (int i = 0; i < 8; ++i) { z[i] = bg[i] * (w2[i] * v[i] + w1[i] * p1[i] + w0[i] * p2[i]); p2[i] = p1[i]; p1[i] = v[i]; }
#pragma unroll
                for (int i = 0; i < 8; ++i) z[i] = __builtin_amdgcn_fmed3f(z[i], -448.0f, 448.0f);
                u32x2 o; o.x = cvt_pk4_fp8(z[0], z[1], z[2], z[3]); o.y = cvt_pk4_fp8(z[4], z[5], z[6], z[7]);
                *(GAS u32x2*)(Zb + (size_t)(t + q) * D + c0) = o;
            }
        }
    }
}

constexpr int AK_STRIDE = 144, AV_STRIDE = 192;
constexpr int AK_OFF = 0, AK_BUF = 64 * AK_STRIDE, AV_OFF = 2 * AK_BUF, AV_BUF = 64 * AV_STRIDE;
constexpr int AF_OFF = AV_OFF + 2 * AV_BUF;
constexpr float ATT_RDONE = 5.9604645e-08f;
__device__ __forceinline__ s16x4 vtr(const LAS unsigned char* p) { return __builtin_bit_cast(s16x4, __builtin_amdgcn_ds_read_tr16_b64_v4i16((LAS s16x4*)p)); }
__device__ __forceinline__ void attn_unit(LAS unsigned char* lds, const bf16_t* Q, const bf16_t* Kg, const bf16_t* Vg, bf16_t* O, int b, int h, int qb) {
    const int tid = opaque_tid(), lane = tid & 63, wid = __builtin_amdgcn_readfirstlane(tid >> 6), r32 = lane & 31, hi = lane >> 5;
    const size_t rowbase = (size_t)b * SEQ;
    const int Tq0 = qb * 256, tq = Tq0 + 32 * wid + r32;
    bf16x8 qf[4];
    { const bf16_t* qp = Q + (rowbase + tq) * D + h * HD + hi * 8;
#pragma unroll
      for (int d0 = 0; d0 < 4; ++d0) qf[d0] = *(const GAS bf16x8*)(qp + 16 * d0); }
    f32x16 o0, o1;
#pragma unroll
    for (int r = 0; r < 16; ++r) { o0[r] = 0.f; o1[r] = 0.f; }
    float R = 1.0f; bool wdone = false;
    LAS int* dflag = (LAS int*)(lds + AF_OFF);
    const int NT = 4 * qb + 4, jw = 4 * qb + (wid >> 1);
    const int srow = tid >> 3, sch = tid & 7;
    const bf16_t* kgp = Kg + (rowbase + srow) * D + h * HD + sch * 8;
    const bf16_t* vgp = Vg + (rowbase + srow) * D + h * HD + sch * 8;
    LAS unsigned char* kst = lds + AK_OFF + srow * AK_STRIDE + sch * 16;
    LAS unsigned char* vst = lds + AV_OFF + srow * AV_STRIDE + sch * 16;
    u32x4 kreg = *(const GAS u32x4*)(kgp + (size_t)(NT - 1) * 64 * D), vreg = *(const GAS u32x4*)(vgp + (size_t)(NT - 1) * 64 * D);
    *(LAS u32x4*)(kst + ((NT - 1) & 1) * AK_BUF) = kreg; *(LAS u32x4*)(vst + ((NT - 1) & 1) * AV_BUF) = vreg;
    __syncthreads();
    const int kr0 = 32 * ((r32 >> 2) & 1) + (r32 & 3) + 4 * (r32 >> 3);
    const int kread = kr0 * AK_STRIDE + hi * 16;
    const int vread = (32 * hi + ((lane & 15) >> 2)) * AV_STRIDE + (16 * ((lane >> 4) & 1) + 4 * (lane & 3)) * 2;
    for (int j = NT - 1; j >= 0; --j) {
        const int buf = j & 1;
        if (j > 0) { kreg = *(const GAS u32x4*)(kgp + (size_t)(j - 1) * 64 * D); vreg = *(const GAS u32x4*)(vgp + (size_t)(j - 1) * 64 * D); }
        if (j <= jw && !wdone) {
            const LAS unsigned char* Kb = lds + AK_OFF + buf * AK_BUF + kread;
            f32x16 p0, p1;
#pragma unroll
            for (int r = 0; r < 16; ++r) { p0[r] = 0.f; p1[r] = 0.f; }
#pragma unroll
            for (int d0 = 0; d0 < 4; ++d0) {
                const bf16x8 k0 = *(const LAS bf16x8*)(Kb + d0 * 32), k1 = *(const LAS bf16x8*)(Kb + 16 * AK_STRIDE + d0 * 32);
                p0 = __builtin_amdgcn_mfma_f32_32x32x16_bf16(k0, qf[d0], p0, 0, 0, 0);
                p1 = __builtin_amdgcn_mfma_f32_32x32x16_bf16(k1, qf[d0], p1, 0, 0, 0);
            }
            const int kb0 = 64 * j + 32 * hi;
            const bool partial = (j == jw);
#pragma unroll
            for (int r = 0; r < 16; ++r) {
                float e0 = __builtin_amdgcn_exp2f(p0[r]), e1 = __builtin_amdgcn_exp2f(p1[r]);
                if (partial) { if (kb0 + r >= tq) e0 = 0.f; if (kb0 + 16 + r >= tq) e1 = 0.f; }
                p0[r] = __builtin_amdgcn_rcpf(1.0f + e0); p1[r] = __builtin_amdgcn_rcpf(1.0f + e1);
            }
            float l = 1.0f;
#pragma unroll
            for (int r = 15; r >= 0; --r) { const float ln = l * p1[r]; p1[r] = l - ln; l = ln; }
#pragma unroll
            for (int r = 15; r >= 0; --r) { const float ln = l * p0[r]; p0[r] = l - ln; l = ln; }
            float T0, T1;
            { auto rr = __builtin_amdgcn_permlane32_swap(__float_as_uint(l), __float_as_uint(l), false, false); T0 = __uint_as_float(rr[0]); T1 = __uint_as_float(rr[1]); }
            const float pre = hi ? R : R * T1;
            R = R * T1 * T0;
            u32x4 pa[4];
#pragma unroll
            for (int q = 0; q < 4; ++q) { pa[0][q] = cvt_pk_bf16(p0[2 * q] * pre, p0[2 * q + 1] * pre); pa[1][q] = cvt_pk_bf16(p0[8 + 2 * q] * pre, p0[9 + 2 * q] * pre);
                                          pa[2][q] = cvt_pk_bf16(p1[2 * q] * pre, p1[2 * q + 1] * pre); pa[3][q] = cvt_pk_bf16(p1[8 + 2 * q] * pre, p1[9 + 2 * q] * pre); }
            const LAS unsigned char* Vb = lds + AV_OFF + buf * AV_BUF + vread;
#pragma unroll
            for (int m = 0; m < 4; ++m) {
                const s16x4 a0 = vtr(Vb + (8 * m) * AV_STRIDE), a1 = vtr(Vb + (8 * m + 4) * AV_STRIDE);
                const s16x4 c0 = vtr(Vb + (8 * m) * AV_STRIDE + 64), c1 = vtr(Vb + (8 * m + 4) * AV_STRIDE + 64);
                const bf16x8 v0 = (bf16x8){a0[0], a0[1], a0[2], a0[3], a1[0], a1[1], a1[2], a1[3]};
                const bf16x8 v1 = (bf16x8){c0[0], c0[1], c0[2], c0[3], c1[0], c1[1], c1[2], c1[3]};
                const bf16x8 pf = __builtin_bit_cast(bf16x8, pa[m]);
                o0 = __builtin_amdgcn_mfma_f32_32x32x16_bf16(pf, v0, o0, 0, 0, 0);
                o1 = __builtin_amdgcn_mfma_f32_32x32x16_bf16(pf, v1, o1, 0, 0, 0);
            }
        }
        if (j > 0) { *(LAS u32x4*)(kst + (buf ^ 1) * AK_BUF) = kreg; *(LAS u32x4*)(vst + (buf ^ 1) * AV_BUF) = vreg; }
        wdone = (j <= jw) && __all(R < ATT_RDONE);
        if (lane == 0) dflag[buf * 8 + wid] = wdone ? 1 : 0;
        __syncthreads();
        { const i32x4 f0 = *(const LAS i32x4*)(dflag + buf * 8), f1 = *(const LAS i32x4*)(dflag + buf * 8 + 4);
          if ((f0[0] & f0[1] & f0[2] & f0[3] & f1[0] & f1[1] & f1[2] & f1[3]) != 0) break; }
    }
    __syncthreads();
    bf16_t* Ow = O + (rowbase + Tq0 + 32 * wid) * D + h * HD + r32;
#pragma unroll
    for (int r = 0; r < 16; ++r) { const int q = (r & 3) + 8 * (r >> 2) + 4 * hi;
        ((GAS bf16_t*)Ow)[(size_t)q * D] = (bf16_t)(cvt_pk_bf16(o0[r], 0.f) & 0xffffu); ((GAS bf16_t*)Ow)[(size_t)q * D + 32] = (bf16_t)(cvt_pk_bf16(o1[r], 0.f) & 0xffffu); }
}

constexpr int AP_K = 64 * AK_STRIDE, AP_V = 64 * AV_STRIDE, AP_PAIR = AP_K + AP_V, AP_FLAG = 4 * AP_PAIR;
__device__ __forceinline__ void attn_unit_pairs(LAS unsigned char* lds, const bf16_t* Q, const bf16_t* Kg, const bf16_t* Vg, bf16_t* O, int b, int h, int qb, int& par, int& psn) {
    const int tid = opaque_tid(), lane = tid & 63, wid = __builtin_amdgcn_readfirstlane(tid >> 6), r32 = lane & 31, hi = lane >> 5;
    const int pair = wid >> 1, ptid = (wid & 1) * 64 + lane;
    const size_t rowbase = (size_t)b * SEQ;
    const int Tq0 = qb * 256, tq = Tq0 + 32 * wid + r32;
    bf16x8 qf[4];
    { const bf16_t* qp = Q + (rowbase + tq) * D + h * HD + hi * 8;
#pragma unroll
      for (int d0 = 0; d0 < 4; ++d0) qf[d0] = *(const GAS bf16x8*)(qp + 16 * d0); }
    f32x16 o0, o1;
#pragma unroll
    for (int r = 0; r < 16; ++r) { o0[r] = 0.f; o1[r] = 0.f; }
    float R = 1.0f;
    LAS int* dflag = (LAS int*)(lds + AP_FLAG);
    LAS int* pcnt = (LAS int*)(lds + AP_FLAG + 256) + pair * 16;
#define PAIR_SYNC() do { asm volatile("s_waitcnt lgkmcnt(0)" ::: "memory"); psn += 2; \
        if (lane == 0) (void)__hip_atomic_fetch_add(pcnt, 1, __ATOMIC_RELAXED, __HIP_MEMORY_SCOPE_WORKGROUP); \
        { int _sp = 0; while (__hip_atomic_load(pcnt, __ATOMIC_RELAXED, __HIP_MEMORY_SCOPE_WORKGROUP) < psn && ++_sp < (1 << 24)) __builtin_amdgcn_s_sleep(0); } \
        asm volatile("" ::: "memory"); } while (0)
    const int jw = 4 * qb + pair;
    LAS unsigned char* Kl = lds + pair * AP_PAIR; LAS unsigned char* Vl = Kl + AP_K;
    const int srow = ptid >> 3, sch = ptid & 7;
    const bf16_t* kgp = Kg + (rowbase + srow) * D + h * HD + sch * 8;
    const bf16_t* vgp = Vg + (rowbase + srow) * D + h * HD + sch * 8;
    LAS unsigned char* kst = Kl + srow * AK_STRIDE + sch * 16; LAS unsigned char* vst = Vl + srow * AV_STRIDE + sch * 16;
    u32x4 kreg[4], vreg[4];
#pragma unroll
    for (int i = 0; i < 4; ++i) { kreg[i] = *(const GAS u32x4*)(kgp + (size_t)(64 * jw + 16 * i) * D); vreg[i] = *(const GAS u32x4*)(vgp + (size_t)(64 * jw + 16 * i) * D); }
#pragma unroll
    for (int i = 0; i < 4; ++i) { *(LAS u32x4*)(kst + 16 * i * AK_STRIDE) = kreg[i]; *(LAS u32x4*)(vst + 16 * i * AV_STRIDE) = vreg[i]; }
    PAIR_SYNC();
    const int kr0 = 32 * ((r32 >> 2) & 1) + (r32 & 3) + 4 * (r32 >> 3);
    const int kread = kr0 * AK_STRIDE + hi * 16;
    const int vread = (32 * hi + ((lane & 15) >> 2)) * AV_STRIDE + (16 * ((lane >> 4) & 1) + 4 * (lane & 3)) * 2;
    bool w_act = true;
    for (int j = jw; ; --j) {
        const bool pf = j > 0 && j == jw;
        if (pf) {
#pragma unroll
            for (int i = 0; i < 4; ++i) { kreg[i] = *(const GAS u32x4*)(kgp + (size_t)(64 * (j - 1) + 16 * i) * D); vreg[i] = *(const GAS u32x4*)(vgp + (size_t)(64 * (j - 1) + 16 * i) * D); }
        }
        if (w_act) {
            const LAS unsigned char* Kb = Kl + kread;
            f32x16 p0, p1;
#pragma unroll
            for (int r = 0; r < 16; ++r) { p0[r] = 0.f; p1[r] = 0.f; }
#pragma unroll
            for (int d0 = 0; d0 < 4; ++d0) {
                const bf16x8 k0 = *(const LAS bf16x8*)(Kb + d0 * 32), k1 = *(const LAS bf16x8*)(Kb + 16 * AK_STRIDE + d0 * 32);
                p0 = __builtin_amdgcn_mfma_f32_32x32x16_bf16(k0, qf[d0], p0, 0, 0, 0);
                p1 = __builtin_amdgcn_mfma_f32_32x32x16_bf16(k1, qf[d0], p1, 0, 0, 0);
            }
            const int kb0 = 64 * j + 32 * hi;
            const bool partial = (j == jw);
            f32x2 W[16];
#pragma unroll
            for (int r = 0; r < 16; ++r) {
                f32x2 E; E.x = __builtin_amdgcn_exp2f(p0[r]); E.y = __builtin_amdgcn_exp2f(p1[r]);
                const f32x2 Dv = E + 1.0f;
                const float rc = __builtin_amdgcn_rcpf(Dv.x * Dv.y);
                W[r] = (f32x2){Dv.y, Dv.x} * rc;
                if (partial) { if (kb0 + r >= tq) W[r].x = 1.0f; if (kb0 + 16 + r >= tq) W[r].y = 1.0f; }
            }
            f32x2 L = (f32x2){1.0f, 1.0f};
#pragma unroll
            for (int r = 15; r >= 0; --r) { const f32x2 LN = L * W[r]; W[r] = L - LN; L = LN; }
            const float l1 = L.y, l = L.x * L.y;
            float T0, T1;
            { auto rr = __builtin_amdgcn_permlane32_swap(__float_as_uint(l), __float_as_uint(l), false, false); T0 = __uint_as_float(rr[0]); T1 = __uint_as_float(rr[1]); }
            const float pre = hi ? R : R * T1;
            const f32x2 PS = (f32x2){pre * l1, pre};
            R = R * T1 * T0;
#pragma unroll
            for (int r = 0; r < 16; ++r) W[r] = W[r] * PS;
            u32x4 pa[4];
#pragma unroll
            for (int q = 0; q < 4; ++q) { pa[0][q] = cvt_pk_bf16(W[2 * q].x, W[2 * q + 1].x); pa[1][q] = cvt_pk_bf16(W[8 + 2 * q].x, W[9 + 2 * q].x);
                                          pa[2][q] = cvt_pk_bf16(W[2 * q].y, W[2 * q + 1].y); pa[3][q] = cvt_pk_bf16(W[8 + 2 * q].y, W[9 + 2 * q].y); }
            const LAS unsigned char* Vb = Vl + vread;
#pragma unroll
            for (int m = 0; m < 4; ++m) {
                const s16x4 a0 = vtr(Vb + (8 * m) * AV_STRIDE), a1 = vtr(Vb + (8 * m + 4) * AV_STRIDE);
                const s16x4 c0 = vtr(Vb + (8 * m) * AV_STRIDE + 64), c1 = vtr(Vb + (8 * m + 4) * AV_STRIDE + 64);
                const bf16x8 v0 = (bf16x8){a0[0], a0[1], a0[2], a0[3], a1[0], a1[1], a1[2], a1[3]};
                const bf16x8 v1 = (bf16x8){c0[0], c0[1], c0[2], c0[3], c1[0], c1[1], c1[2], c1[3]};
                const bf16x8 pf2 = __builtin_bit_cast(bf16x8, pa[m]);
                o0 = __builtin_amdgcn_mfma_f32_32x32x16_bf16(pf2, v0, o0, 0, 0, 0);
                o1 = __builtin_amdgcn_mfma_f32_32x32x16_bf16(pf2, v1, o1, 0, 0, 0);
            }
            w_act = (j > 0) && !__all(R < ATT_RDONE);
        }
        if (lane == 0) dflag[par * 8 + wid] = w_act ? 0 : 1;
        PAIR_SYNC();
        const int fa = dflag[par * 8 + 2 * pair] & dflag[par * 8 + 2 * pair + 1];
        par ^= 1;
        if (fa != 0) break;
        if (j > 0) {
            if (!pf) {
#pragma unroll
                for (int i = 0; i < 4; ++i) { kreg[i] = *(const GAS u32x4*)(kgp + (size_t)(64 * (j - 1) + 16 * i) * D); vreg[i] = *(const GAS u32x4*)(vgp + (size_t)(64 * (j - 1) + 16 * i) * D); }
            }
#pragma unroll
            for (int i = 0; i < 4; ++i) { *(LAS u32x4*)(kst + 16 * i * AK_STRIDE) = kreg[i]; *(LAS u32x4*)(vst + 16 * i * AV_STRIDE) = vreg[i]; }
        }
        PAIR_SYNC();
    }
    {
        const int j4 = r32 & 3, m4 = r32 >> 2;
        const unsigned selj = (unsigned)j4 | ((unsigned)(4 + j4) << 8) | 0x0c0c0000u;
        unsigned char* Ow = (unsigned char*)O + (rowbase + Tq0 + 32 * wid + j4 + 4 * hi) * D + h * HD + 4 * m4;
#pragma unroll
        for (int half = 0; half < 2; ++half)
#pragma unroll
            for (int k = 0; k < 4; ++k) {
                const unsigned bw = half == 0 ? cvt_pk4_fp8(o0[4 * k], o0[4 * k + 1], o0[4 * k + 2], o0[4 * k + 3]) : cvt_pk4_fp8(o1[4 * k], o1[4 * k + 1], o1[4 * k + 2], o1[4 * k + 3]);
                const unsigned q0 = (unsigned)__builtin_amdgcn_update_dpp(0, (int)bw, 0x00, 0xf, 0xf, false), q1 = (unsigned)__builtin_amdgcn_update_dpp(0, (int)bw, 0x55, 0xf, 0xf, false);
                const unsigned q2 = (unsigned)__builtin_amdgcn_update_dpp(0, (int)bw, 0xaa, 0xf, 0xf, false), q3 = (unsigned)__builtin_amdgcn_update_dpp(0, (int)bw, 0xff, 0xf, 0xf, false);
                const unsigned t01 = __builtin_amdgcn_perm(q1, q0, selj), t23 = __builtin_amdgcn_perm(q3, q2, selj);
                const unsigned dv = __builtin_amdgcn_perm(t23, t01, 0x05040100u);
                *(GAS unsigned*)(Ow + (size_t)(8 * k) * D + 32 * half) = dv;
            }
    }
#undef PAIR_SYNC
}

constexpr int RT_WSTRIDE = 2064;
constexpr int RT_LG_OFF = 32 * RT_WSTRIDE;
constexpr int RT_HIST_OFF = RT_LG_OFF + 8 * 16 * 33 * 4;
__device__ __forceinline__ void router_phase(LAS unsigned char* lds, const bf16_t* h, const bf16_t* wrt  , const float* rb, unsigned* gcnt, int* toks, float* gl, int* slot, int vcu, int G) {
    const int tid = opaque_tid(), lane = tid & 63, wave = __builtin_amdgcn_readfirstlane(tid >> 6);
    for (int i = tid; i < 32 * 128; i += NWAVES * 64) { const int e = i >> 7, ch = i & 127; *(LAS u32x4*)(lds + e * RT_WSTRIDE + ch * 16) = *(const GAS u32x4*)(wrt + (size_t)e * D + ch * 8); }
    LAS int* lcnt = (LAS int*)(lds + RT_HIST_OFF); LAS int* lbase = lcnt + 32;
    LAS float* lg = (LAS float*)(lds + RT_LG_OFF) + wave * 16 * 33;
    __syncthreads();
    const int r16 = lane & 15, kq = lane >> 4;
    for (int chunk = vcu; chunk < NTOK / 256; chunk += G) {
        if (tid < 32) lcnt[tid] = 0;
        __syncthreads();
        int se[2][4], sp[2][4]; float sg[2][4];
#pragma unroll
        for (int g = 0; g < 2; ++g) {
            const int row0 = chunk * 256 + wave * 32 + g * 16;
            f32x4 a0 = (f32x4){0.f, 0.f, 0.f, 0.f}, a1 = a0;
            const bf16_t* hp = h + (size_t)(row0 + r16) * D + 8 * kq;
            const LAS unsigned char* wp = lds + r16 * RT_WSTRIDE + kq * 16;
            bf16x8 av[32];
#pragma unroll
            for (int ks = 0; ks < 32; ++ks) av[ks] = *(const GAS bf16x8*)(hp + 32 * ks);
#pragma unroll
            for (int ks = 0; ks < 32; ++ks) {
                const bf16x8 b0 = *(const LAS bf16x8*)(wp + ks * 64), b1 = *(const LAS bf16x8*)(wp + 16 * RT_WSTRIDE + ks * 64);
                a0 = __builtin_amdgcn_mfma_f32_16x16x32_bf16(av[ks], b0, a0, 0, 0, 0);
                a1 = __builtin_amdgcn_mfma_f32_16x16x32_bf16(av[ks], b1, a1, 0, 0, 0);
            }
#pragma unroll
            for (int i = 0; i < 4; ++i) { lg[(4 * kq + i) * 33 + r16] = a0[i]; lg[(4 * kq + i) * 33 + 16 + r16] = a1[i]; }
            LDS_WAIT(); asm volatile("" ::: "memory");
            if (lane < 16) {
                float v[32];
#pragma unroll
                for (int e = 0; e < 32; ++e) v[e] = lg[lane * 33 + e] + rb[e];
                unsigned used = 0u; float tv[4];
#pragma unroll
                for (int k = 0; k < 4; ++k) {
                    float best = -INFINITY; int bi = 0;
#pragma unroll
                    for (int e = 0; e < 32; ++e) { const bool ok = !((used >> e) & 1u) && (v[e] > best); best = ok ? v[e] : best; bi = ok ? e : bi; }
                    used |= 1u << bi; se[g][k] = bi; tv[k] = best;
                }
                const float e1 = __expf(tv[1] - tv[0]), e2 = __expf(tv[2] - tv[0]), e3 = __expf(tv[3] - tv[0]);
                const float inv = 1.0f / (1.0f + e1 + e2 + e3);
                sg[g][0] = inv; sg[g][1] = e1 * inv; sg[g][2] = e2 * inv; sg[g][3] = e3 * inv;
#pragma unroll
                for (int k = 0; k < 4; ++k) sp[g][k] = __hip_atomic_fetch_add(&lcnt[se[g][k]], 1, __ATOMIC_RELAXED, __HIP_MEMORY_SCOPE_WORKGROUP);
            }
            LDS_WAIT(); asm volatile("" ::: "memory");
        }
        __syncthreads();
        if (tid < 32) lbase[tid] = (int)__hip_atomic_fetch_add(gcnt + tid, (unsigned)lcnt[tid], RLX_AGENT);
        __syncthreads();
        if (lane < 16) {
#pragma unroll
            for (int g = 0; g < 2; ++g) {
                const int tok = chunk * 256 + wave * 32 + g * 16 + lane;
#pragma unroll
                for (int k = 0; k < 4; ++k) { const int e = se[g][k], pos = lbase[e] + sp[g][k];
                    ((GAS int*)toks)[(size_t)e * CAP + pos] = tok; ((GAS float*)gl)[(size_t)e * CAP + pos] = sg[g][k]; ((GAS int*)slot)[tok * 4 + k] = (e << 16) | pos; }
            }
        }
        __syncthreads();
    }
}
constexpr int NR_TSTRIDE = 528;
constexpr int NR_TILE_OFF = 32 * RT_WSTRIDE;
constexpr int NR_LG_OFF = NR_TILE_OFF + 8 * 16 * NR_TSTRIDE;
constexpr int NR_HIST_OFF = NR_LG_OFF + 8 * 16 * 33 * 4;
static_assert(NR_HIST_OFF + 256 <= LDSCTL_OFF, "norm+router scratch fits under the control words");
__device__ __forceinline__ void normrouter_phase(LAS unsigned char* lds, const bf16_t* __restrict__ x, const float* g, const float* modl, unsigned char* __restrict__ h8, const bf16_t* wrt, const float* rb,
                                                 unsigned* gcnt, int* toks, float* gl, int* slot, int vcu, int G) {
    const int tid = opaque_tid(), lane = tid & 63, wave = __builtin_amdgcn_readfirstlane(tid >> 6);
    for (int i = tid; i < 32 * 128; i += NWAVES * 64) { const int e = i >> 7, ch = i & 127; *(LAS u32x4*)(lds + e * RT_WSTRIDE + ch * 16) = *(const GAS u32x4*)(wrt + (size_t)e * D + ch * 8); }
    LAS int* lcnt = (LAS int*)(lds + NR_HIST_OFF); LAS int* lbase = lcnt + 32;
    LAS float* lg = (LAS float*)(lds + NR_LG_OFF) + wave * 16 * 33;
    LAS unsigned char* tile = lds + NR_TILE_OFF + wave * 16 * NR_TSTRIDE;
    __syncthreads();
    const int r16 = lane & 15, kq = lane >> 4;
    for (int chunk = vcu; chunk < NTOK / 256; chunk += G) {
        if (tid < 32) lcnt[tid] = 0;
        __syncthreads();
        const int row0 = chunk * 256 + wave * 32, b = row0 / SEQ;
        int se[2][4], sp[2][4]; float sg[2][4];
#pragma unroll
        for (int gI = 0; gI < 2; ++gI) {
            const int r0 = row0 + gI * 16;
            u32x2 raw[16][4];
#pragma unroll
            for (int q = 0; q < 16; ++q) { const GAS u32x2* xr = (const GAS u32x2*)(x + (size_t)(r0 + q) * D) + lane;
#pragma unroll
                for (int j = 0; j < 4; ++j) raw[q][j] = xr[64 * j]; }
            float rinv[16];
#pragma unroll
            for (int q = 0; q < 16; ++q) {
                float ssum = 0.f;
#pragma unroll
                for (int j = 0; j < 4; ++j) { const float x0 = bf_lo(raw[q][j].x), x1 = bf_hi(raw[q][j].x), x2 = bf_lo(raw[q][j].y), x3 = bf_hi(raw[q][j].y); ssum += (x0 * x0 + x1 * x1) + (x2 * x2 + x3 * x3); }
                rinv[q] = rsqrtf(wave_sum(ssum) * (1.0f / D) + EPS);
            }
            f32x4 a0 = (f32x4){0.f, 0.f, 0.f, 0.f}, a1 = a0;
            const LAS unsigned char* ap = tile + r16 * NR_TSTRIDE + kq * 16;
#pragma unroll
            for (int j = 0; j < 4; ++j) {
                const int cidx = 4 * lane + 256 * j;
                const f32x4 avj = *(const GAS f32x4*)(g + cidx) * (*(const GAS f32x4*)(modl + (size_t)b * 6144 + 4096 + cidx) + 1.0f), svj = *(const GAS f32x4*)(modl + (size_t)b * 6144 + 3072 + cidx);
#pragma unroll
                for (int q = 0; q < 16; ++q) {
                    unsigned rwx = raw[q][j].x, rwy = raw[q][j].y; asm volatile("" : "+v"(rwx), "+v"(rwy));
                    const f32x4 xv = (f32x4){bf_lo(rwx), bf_hi(rwx), bf_lo(rwy), bf_hi(rwy)};
                    const f32x4 y = xv * rinv[q] * avj + svj;
                    u32x2 w2; w2.x = cvt_pk_bf16(y.x, y.y); w2.y = cvt_pk_bf16(y.z, y.w);
                    *((LAS u32x2*)(tile + q * NR_TSTRIDE) + lane) = w2;
                    *((GAS unsigned*)(h8 + (size_t)(r0 + q) * D + 256 * j) + lane) = cvt_pk4_fp8(y.x, y.y, y.z, y.w);
                }
                LDS_WAIT(); asm volatile("" ::: "memory");
                const LAS unsigned char* wp = lds + r16 * RT_WSTRIDE + kq * 16 + j * 512;
#pragma unroll
                for (int ks = 0; ks < 8; ++ks) {
                    const bf16x8 afr = *(const LAS bf16x8*)(ap + ks * 64);
                    const bf16x8 b0 = *(const LAS bf16x8*)(wp + ks * 64), b1 = *(const LAS bf16x8*)(wp + 16 * RT_WSTRIDE + ks * 64);
                    a0 = __builtin_amdgcn_mfma_f32_16x16x32_bf16(afr, b0, a0, 0, 0, 0);
                    a1 = __builtin_amdgcn_mfma_f32_16x16x32_bf16(afr, b1, a1, 0, 0, 0);
                }
                LDS_WAIT(); asm volatile("" ::: "memory");
            }
            { const float rb0 = ((const GAS float*)rb)[r16], rb1 = ((const GAS float*)rb)[16 + r16];
#pragma unroll
              for (int i = 0; i < 4; ++i) { lg[(4 * kq + i) * 33 + r16] = a0[i] + rb0; lg[(4 * kq + i) * 33 + 16 + r16] = a1[i] + rb1; } }
            LDS_WAIT(); asm volatile("" ::: "memory");
            float tv[4];
            {
                const int prt = lane >> 4;
                float v[8];
#pragma unroll
                for (int i = 0; i < 8; ++i) v[i] = lg[(lane & 15) * 33 + 8 * prt + i];
                unsigned used = 0u;
#pragma unroll
                for (int k = 0; k < 4; ++k) {
                    float best = -INFINITY; int bi = 8 * prt;
#pragma unroll
                    for (int i = 0; i < 8; ++i) { const bool ok = !((used >> i) & 1u) && (v[i] > best); best = ok ? v[i] : best; bi = ok ? 8 * prt + i : bi; }
#pragma unroll
                    for (int st = 16; st <= 32; st <<= 1) { const float ob = __shfl_xor(best, st); const int oi = __shfl_xor(bi, st); const bool take = (ob > best) || (ob == best && oi < bi); best = take ? ob : best; bi = take ? oi : bi; }
                    if ((bi >> 3) == prt) used |= 1u << (bi & 7);
                    se[gI][k] = bi; tv[k] = best;
                }
            }
            if (lane < 16) {
                const float e1 = __expf(tv[1] - tv[0]), e2 = __expf(tv[2] - tv[0]), e3 = __expf(tv[3] - tv[0]);
                const float inv = 1.0f / (1.0f + e1 + e2 + e3);
                sg[gI][0] = inv; sg[gI][1] = e1 * inv; sg[gI][2] = e2 * inv; sg[gI][3] = e3 * inv;
#pragma unroll
                for (int k = 0; k < 4; ++k) sp[gI][k] = __hip_atomic_fetch_add(&lcnt[se[gI][k]], 1, __ATOMIC_RELAXED, __HIP_MEMORY_SCOPE_WORKGROUP);
            }
            LDS_WAIT(); asm volatile("" ::: "memory");
        }
        __syncthreads();
        { const int t2 = opaque_tid();
          if (t2 < 32) lbase[t2] = (int)__hip_atomic_fetch_add((unsigned*)opaque_ptr((unsigned char*)gcnt) + t2, (unsigned)lcnt[t2], RLX_AGENT); }
        __syncthreads();
        if (lane < 16) {
#pragma unroll
            for (int gI = 0; gI < 2; ++gI) {
                const int tok = row0 + gI * 16 + lane;
#pragma unroll
                for (int k = 0; k < 4; ++k) { const int e = se[gI][k], pos = lbase[e] + sp[gI][k];
                    ((GAS int*)toks)[(size_t)e * CAP + pos] = tok; ((GAS float*)gl)[(size_t)e * CAP + pos] = sg[gI][k]; ((GAS int*)slot)[tok * 4 + k] = (e << 16) | pos; }
            }
        }
        __syncthreads();
    }
}
__device__ __forceinline__ void moe_tables(LAS int* tab, unsigned* gcnt) {
    const int tid = opaque_tid();
    __syncthreads();
    if (tid < 32) tab[40 + tid] = (int)__hip_atomic_load(gcnt + tid, RLX_AGENT);
    __syncthreads();
    if (tid == 0) { int s = 0; for (int e = 0; e < 32; ++e) { tab[e] = s; s += (tab[40 + e] + 255) >> 8; } tab[32] = s; }
    __syncthreads();
    { LAS int* tinfo = tab + (TINFO_OFF - TAB_OFF) / 4; const int Tm = tab[32];
      for (int mt = tid; mt < Tm; mt += NWAVES * 64) { int e = 0;
#pragma unroll
          for (int s = 16; s >= 1; s >>= 1) { if (tab[e + s] <= mt) e += s; }
          tinfo[mt] = (e << 16) | (mt - tab[e]); } }
    __syncthreads();
}
__device__ __forceinline__ void combine_phase(bf16_t* x, float* xfinal, const unsigned char* __restrict__ Y, const int* __restrict__ slot, const float* __restrict__ gl, const LAS int* tab, const float* modl, bool donorm, const float* gn, const float* modn, bf16_t* __restrict__ h, unsigned char* __restrict__ h8, int vcu, int G) {
    const int tid = opaque_tid(), lane = tid & 63, gw = vcu * NWAVES + __builtin_amdgcn_readfirstlane(tid >> 6), NGW = G * NWAVES;
    for (int w = gw; w < NTOK / 32; w += NGW) {
        const int row0 = w * 32, b = row0 / SEQ;
        f32x4 gtv[4], av[4], sv[4];
#pragma unroll
        for (int j = 0; j < 4; ++j) { const int cidx = 4 * lane + 256 * j; gtv[j] = *(const GAS f32x4*)(modl + (size_t)b * 6144 + 5120 + cidx);
            if (donorm) { av[j] = *(const GAS f32x4*)(gn + cidx) * (*(const GAS f32x4*)(modn + (size_t)b * 6144 + 1024 + cidx) + 1.0f); sv[j] = *(const GAS f32x4*)(modn + (size_t)b * 6144 + cidx); }
            else { av[j] = (f32x4){0.f, 0.f, 0.f, 0.f}; sv[j] = av[j]; } }
        i32x4 sl[2];
#pragma unroll
        for (int q = 0; q < 2; ++q) sl[q] = *(const GAS i32x4*)(slot + (row0 + q) * 4);
#pragma nounroll
        for (int r = 0; r < 32; r += 2) {
            unsigned yv[2][4][4]; f32x4 xv[2][4]; float gk[2][4];
            i32x4 sn[2];
            { const int rn = (r + 2 < 32) ? r + 2 : r;
#pragma unroll
              for (int q = 0; q < 2; ++q) sn[q] = *(const GAS i32x4*)(slot + (row0 + rn + q) * 4); }
#pragma unroll
            for (int q = 0; q < 2; ++q) {
                const int tok = row0 + r + q;
                const i32x4 s4 = sl[q];
#pragma unroll
                for (int k = 0; k < 4; ++k) { const int sk = s4[k]; const int e = sk >> 16, pos = sk & 0xffff; const int yrow = tab[e] * 256 + pos;
                    gk[q][k] = ((const GAS float*)gl)[(size_t)e * CAP + pos];
                    const GAS unsigned* yp = (const GAS unsigned*)(Y + (size_t)yrow * D) + lane;
#pragma unroll
                    for (int j = 0; j < 4; ++j) yv[q][k][j] = __builtin_nontemporal_load(yp + 64 * j); }
                const GAS u32x2* xr = (const GAS u32x2*)(x + (size_t)tok * D) + lane;
#pragma unroll
                for (int j = 0; j < 4; ++j) { const u32x2 w = xr[64 * j]; xv[q][j] = (f32x4){bf_lo(w.x), bf_hi(w.x), bf_lo(w.y), bf_hi(w.y)}; }
            }
#pragma unroll
            for (int q = 0; q < 2; ++q) {
                const int tok = row0 + r + q;
                GAS u32x2* xw = (GAS u32x2*)(x + (size_t)tok * D) + lane; GAS f32x4* xf = (GAS f32x4*)(xfinal + (size_t)tok * D) + lane;
                f32x4 v[4]; float ss = 0.f;
#pragma unroll
                for (int j = 0; j < 4; ++j) {
                    f32x4 s4 = (f32x4){0.f, 0.f, 0.f, 0.f};
#pragma unroll
                    for (int k = 0; k < 4; ++k) { const unsigned yy = yv[q][k][j]; const f32x2 lo = __builtin_amdgcn_cvt_pk_f32_fp8((int)yy, false), hi2 = __builtin_amdgcn_cvt_pk_f32_fp8((int)yy, true); const float gg = gk[q][k]; s4.x += gg * lo[0]; s4.y += gg * lo[1]; s4.z += gg * hi2[0]; s4.w += gg * hi2[1]; }
                    v[j] = xv[q][j] + gtv[j] * s4;
                    if (xfinal) __builtin_nontemporal_store(v[j], xf + 64 * j); else { u32x2 w2; w2.x = cvt_pk_bf16(v[j].x, v[j].y); w2.y = cvt_pk_bf16(v[j].z, v[j].w); xw[64 * j] = w2; }
                    ss += (v[j].x * v[j].x + v[j].y * v[j].y) + (v[j].z * v[j].z + v[j].w * v[j].w);
                }
                if (donorm) {
                    const float rinv = rsqrtf(wave_sum(ss) * (1.0f / D) + EPS);
                    GAS u32x2* o8 = (GAS u32x2*)(h + (size_t)tok * D) + lane; GAS unsigned* o4 = (GAS unsigned*)(h8 + (size_t)tok * D) + lane;
#pragma unroll
                    for (int j = 0; j < 4; ++j) { const f32x4 y = v[j] * rinv * av[j] + sv[j];
                        if (h8) o4[64 * j] = cvt_pk4_fp8(y.x, y.y, y.z, y.w);
                        else { u32x2 w2; w2.x = cvt_pk_bf16(y.x, y.y); w2.y = cvt_pk_bf16(y.z, y.w); o8[64 * j] = w2; } }
                }
            }
            sl[0] = sn[0]; sl[1] = sn[1];
        }
    }
}

__global__ void __launch_bounds__(NWAVES * 64, 2) fwd_kernel(Args args) {
    extern __shared__ __attribute__((aligned(16))) unsigned char lds_raw[];
    LAS unsigned char* lds = (LAS unsigned char*)lds_raw;
    const int G = gridDim.x; const int bx = blockIdx.x; const int vcu = (G % 8 == 0) ? (bx % 8) * (G / 8) + bx / 8 : bx;
    gu32* ctl = (gu32*)(args.ws + WS_CTL);
    for (int u = threadIdx.x; u < (LDS_BYTES - LDSCTL_OFF) / 4; u += NWAVES * 64) ((LAS unsigned*)(lds + LDSCTL_OFF))[u] = 0u;
    __syncthreads();
    (void)xcd_barrier_post((unsigned*)(ctl + CW_BAR), (volatile LAS unsigned*)(lds + MISC_OFF));
    if (threadIdx.x == 0) (void)__hip_atomic_fetch_or((unsigned*)(ctl + CW_GRPMASK + (bx & 7)), 1u << xb_xcc_id(), __ATOMIC_RELAXED, __HIP_MEMORY_SCOPE_AGENT);
#define GRID_BAR() do { XcdBarrier _b; _b.bar = (unsigned*)((gu32*)(opaque_ptr(args.ws) + WS_CTL) + CW_BAR); _b.x = xb_xcc_id(); _b.st = (volatile LAS unsigned*)(lds + MISC_OFF); xcd_barrier(_b); } while (0)
    LAS int* tab = (LAS int*)(lds + TAB_OFF);

#define LOCAL_SYNC() do { asm volatile("s_waitcnt vmcnt(0)" ::: "memory"); __syncthreads(); } while (0)
#define WSP(off) (opaque_ptr(args.ws) + (off))
    prologue(args, lds, vcu, G);
    GRID_BAR();
    int fastgrp = 0; unsigned ggen = 0u;
    { if (threadIdx.x == 0) { unsigned ok = (G % 8 == 0) ? 1u : 0u;
#pragma unroll
          for (int g8 = 0; g8 < 8; ++g8) { const unsigned m = xb_ld((unsigned*)(ctl + CW_GRPMASK + g8)); ok &= (m != 0u && (m & (m - 1u)) == 0u) ? 1u : 0u; }
          ((volatile LAS unsigned*)(lds + MISC_OFF))[4] = ok; }
      __syncthreads();
      fastgrp = (int)((volatile LAS unsigned*)(lds + MISC_OFF))[4]; }
#define GROUP_BAR() do { if (fastgrp) { asm volatile("s_waitcnt vmcnt(0)" ::: "memory"); __syncthreads(); ggen += (unsigned)(G >> 3); \
        if (threadIdx.x == 0) { unsigned* _gb = (unsigned*)((gu32*)(opaque_ptr(args.ws) + WS_CTL) + CW_GB + 64 * (bx & 7)); unsigned* _bb = (unsigned*)((gu32*)(opaque_ptr(args.ws) + WS_CTL) + CW_BAR); \
            (void)xb_add(_gb, 1u); XB_SPIN(xb_ld(_gb) < ggen, _bb); asm volatile("s_waitcnt vmcnt(0)" ::: "memory"); } \
        __syncthreads(); } else { GRID_BAR(); } } while (0)
    norm_phase(args.x, args.norm1_g, (const float*)WSP(WS_MOD), 0, 1024, (bf16_t*)WSP(WS_H), nullptr, vcu, G);
    GROUP_BAR();

#pragma nounroll
    for (int l = 0; l < DEPTH; ++l) {
        const int j = l >> 1;
        if ((l & 1) == 0) {
            { pg8::StaticOrder S; S.init(NTOK, 3072, opaque_sint(G), opaque_sint(bx)); pg8::EpiConvIn E{(bf16_t*)WSP(WS_A1), (bf16_t*)WSP(WS_A2)};
              pg8::gemm_phase<pg8::EpiConvIn, pg8::StaticOrder, true, 2>(lds, WSP(WS_H), WSP(WS_WCIN) + (size_t)j * 3072 * D * 2, D, S, E); }
            GROUP_BAR();
            conv_phase((const bf16_t*)WSP(WS_A1), (const bf16_t*)WSP(WS_A2), args.conv_w + (size_t)j * 3 * D, WSP(WS_A3), vcu, G);
            LOCAL_SYNC();
            { pg8::PanelOrderG S; S.init(NTOK, D, opaque_sint(G), opaque_sint(vcu)); if (l == 0) { pg8::EpiResidT<true> E{args.x, (bf16_t*)WSP(WS_XB), (const float*)WSP(WS_MOD) + (size_t)l * NB * 6144 + 2048};
                pg8::gemm_phase<pg8::EpiResidT<true>, pg8::PanelOrderG, true, 1>(lds, WSP(WS_A3), WSP(WS_WCOUT) + (size_t)j * D * D, D, S, E); }
              else { pg8::EpiResidT<false> E{WSP(WS_XB), (bf16_t*)WSP(WS_XB), (const float*)WSP(WS_MOD) + (size_t)l * NB * 6144 + 2048};
                pg8::gemm_phase<pg8::EpiResidT<false>, pg8::PanelOrderG, true, 1>(lds, WSP(WS_A3), WSP(WS_WCOUT) + (size_t)j * D * D, D, S, E); } }
            LOCAL_SYNC();
        } else {
            { LAS float* qkg = (LAS float*)(lds + RING_BYTES); const int t_ = opaque_tid();
              if (t_ < 128) qkg[t_] = t_ < 64 ? ((const GAS float*)args.attn_q_g)[j * HD + t_] * C2 : ((const GAS float*)args.attn_k_g)[j * HD + t_ - 64];
              __syncthreads(); }
            { pg8::StaticOrderG S; S.init(NTOK, 3072, opaque_sint(G), opaque_sint(bx)); pg8::EpiQKV E{(bf16_t*)WSP(WS_A1), (bf16_t*)WSP(WS_A2), (bf16_t*)WSP(WS_A3), (const LAS float*)(lds + RING_BYTES)};
              pg8::gemm_phase<pg8::EpiQKV, pg8::StaticOrderG, true, 1>(lds, WSP(WS_H8), WSP(WS_WQKV) + (size_t)j * 3072 * D, D, S, E); }
            GROUP_BAR();
            int apar = 0, apsn = 0;
            { const int t_ = opaque_tid(); if (t_ < 4) ((LAS int*)(lds + AP_FLAG + 256))[t_ * 16] = 0; __syncthreads(); }
            for (int pn = vcu; pn < NB * (SEQ / 256); pn += G)
                for (int hh = 0; hh < NH; ++hh) attn_unit_pairs(lds, (const bf16_t*)WSP(WS_A1), (const bf16_t*)WSP(WS_A2), (const bf16_t*)WSP(WS_A3), (bf16_t*)WSP(WS_H), pn / (SEQ / 256), hh, pn % (SEQ / 256), apar, apsn);
            LOCAL_SYNC();
            { pg8::PanelOrderG S; S.init(NTOK, D, opaque_sint(G), opaque_sint(vcu)); pg8::EpiResidT<false> E{WSP(WS_XB), (bf16_t*)WSP(WS_XB), (const float*)WSP(WS_MOD) + (size_t)l * NB * 6144 + 2048};
              pg8::gemm_phase<pg8::EpiResidT<false>, pg8::PanelOrderG, true, 1>(lds, WSP(WS_H), WSP(WS_WO) + (size_t)j * D * D, D, S, E); }
            LOCAL_SYNC();
        }
        normrouter_phase(lds, (const bf16_t*)WSP(WS_XB), args.norm2_g + (size_t)l * D, (const float*)WSP(WS_MOD) + (size_t)l * NB * 6144, WSP(WS_H8), (const bf16_t*)WSP(WS_WR) + (size_t)l * NE * D, args.router_b + l * NE,
                         (unsigned*)((gu32*)WSP(WS_CTL) + CW_CNT + l * 32), (int*)WSP(WS_TOK), (float*)WSP(WS_GL), (int*)WSP(WS_SLOT), vcu, G);
        GRID_BAR();
        moe_tables(tab, (unsigned*)((gu32*)WSP(WS_CTL) + CW_CNT + l * 32));
        { pg8::MoeOrderT<true> S; S.init(tab, (const int*)WSP(WS_TOK), 8, opaque_sint(G), opaque_sint(bx)); pg8::EpiMoe1 E{WSP(WS_ACT), args.moe_b1 + (size_t)l * NE * 2048};
          pg8::gemm_phase<pg8::EpiMoe1, pg8::MoeOrderT<true>, true, 1>(lds, WSP(WS_H8), WSP(WS_W1) + (size_t)l * NE * 2048 * D, D, S, E); }
        GRID_BAR();
        { pg8::MoeOrderI S; S.init(tab, (const int*)WSP(WS_TOK), 4, opaque_sint(G), opaque_sint(bx)); pg8::EpiMoe2 E{WSP(WS_Y), args.moe_b2 + (size_t)l * NE * D, (const float*)WSP(WS_GL), tab};
          pg8::gemm_phase<pg8::EpiMoe2, pg8::MoeOrderI, true, 1>(lds, WSP(WS_ACT), WSP(WS_W2) + (size_t)l * NE * D * FF, FF, S, E); }
        GRID_BAR();
        { const bool dn = (l + 1 < DEPTH);
          combine_phase((bf16_t*)WSP(WS_XB), dn ? (float*)nullptr : args.out, WSP(WS_Y), (const int*)WSP(WS_SLOT), (const float*)WSP(WS_GL), tab, (const float*)WSP(WS_MOD) + (size_t)l * NB * 6144, dn, args.norm1_g + (size_t)(dn ? l + 1 : l) * D, (const float*)WSP(WS_MOD) + (size_t)(dn ? l + 1 : l) * NB * 6144, (bf16_t*)WSP(WS_H), ((l & 1) == 0) ? WSP(WS_H8) : (unsigned char*)nullptr, vcu, G); }
        if (l + 1 < DEPTH) GROUP_BAR();
    }
}

extern "C" void kernel_launch(void* const* d_in, const int* in_sizes, int n_in, void* d_out, int out_size, void* d_ws, size_t ws_size, hipStream_t stream) {
    static int grid = 0;
    if (grid == 0) {
        if (n_in != 19 || out_size != NTOK * D || ws_size < WS_END) { fprintf(stderr, "kernel_launch: unexpected shapes (n_in %d out %d ws %zu)\n", n_in, out_size, ws_size); grid = -1; return; }
        int dev = 0, cus = 0, per_cu = 0;
        if (hipGetDevice(&dev) != hipSuccess || hipDeviceGetAttribute(&cus, hipDeviceAttributeMultiprocessorCount, dev) != hipSuccess) { grid = -1; return; }
        if (hipFuncSetAttribute((const void*)fwd_kernel, hipFuncAttributeMaxDynamicSharedMemorySize, LDS_BYTES) != hipSuccess) { fprintf(stderr, "kernel_launch: hipFuncSetAttribute failed\n"); grid = -1; return; }
        if (hipOccupancyMaxActiveBlocksPerMultiprocessor(&per_cu, (const void*)fwd_kernel, NWAVES * 64, LDS_BYTES) != hipSuccess || per_cu < 1) { fprintf(stderr, "kernel_launch: occupancy query says %d\n", per_cu); }
        (void)hipGetLastError();
        grid = cus;
    }
    if (grid < 0) return;
    if (hipMemsetAsync((char*)d_ws + WS_CTL, 0, CTL_ZERO_BYTES, stream) != hipSuccess) return;
    Args a{};
    const float* const* in = (const float* const*)d_in;
    a.x = in[0]; a.c = in[1]; a.norm1_g = in[2]; a.norm2_g = in[3]; a.ada_w = in[4]; a.ada_b = in[5]; a.conv_w_in = in[6]; a.conv_w = in[7]; a.conv_w_out = in[8];
    a.attn_w_qkv = in[9]; a.attn_q_g = in[10]; a.attn_k_g = in[11]; a.attn_w_o = in[12]; a.router_w = in[13]; a.router_b = in[14]; a.moe_w1 = in[15]; a.moe_b1 = in[16];
    a.moe_w2 = in[17]; a.moe_b2 = in[18]; a.out = (float*)d_out; a.ws = (unsigned char*)d_ws;
    hipLaunchKernelGGL(fwd_kernel, dim3(grid), dim3(NWAVES * 64), LDS_BYTES, stream, a);
}
```
